# Optimizing an MI355X kernel written in HIP

```python
import jax, jax.numpy as jnp
from jax import lax
import numpy as np

D_MODEL = 1024
BATCH = 1
SEQ = 16384
DEPTH = 1
DEC_BATCH = 32
DEC_SEQ = 2048
PAST_LEN = 128

HEAD_DIM = 64
ATTN_WIDTH = D_MODEL // 2
ATTN_HEADS = ATTN_WIDTH // HEAD_DIM
RWKV_WIDTH = D_MODEL - ATTN_WIDTH
RWKV_HEADS = RWKV_WIDTH // HEAD_DIM
DECAY_RANK = 64
ICLR_RANK = 64
GATE_RANK = 128
D_FF = 4 * D_MODEL
DILATION_PATTERNS = ((128, 1), (512, 4), (2048, 16))
ATTN_IN = 3 * ATTN_WIDTH
RWKV_IN = 3 * RWKV_WIDTH + 2 * DECAY_RANK + 2 * ICLR_RANK + GATE_RANK
IN_WIDTH = ATTN_IN + RWKV_IN
NORM_EPS = 1e-6
LN_X_EPS = 64e-5
NEG_INF = -1e30

kernel_name = 'hymba_longnet_rwkv7_adaln_encoder'


def rmsnorm(x, g):
    x32 = x.astype(jnp.float32)
    y = x32 * lax.rsqrt(jnp.mean(x32 * x32, axis=-1, keepdims=True) + NORM_EPS) * g
    return y.astype(x.dtype)


def alibi_slopes(n_heads):
    return 2.0 ** (-8.0 * (jnp.arange(n_heads, dtype=jnp.float32) + 1.0) / n_heads)


def dilated_band_attention(q, k, v, dil, half, slopes):
    B, S, H, Dh = q.shape
    L = S // dil
    nb = -(-L // half)
    Lp = nb * half
    N = B * dil

    def to_sub(z):
        return z.reshape(B, L, dil, H, Dh).transpose(0, 2, 1, 3, 4).reshape(N, L, H, Dh)

    def band(z):
        zp = jnp.pad(z, ((0, 0), (half, Lp - L + half), (0, 0), (0, 0))).reshape(N, nb + 2, half, H, Dh)
        return jnp.concatenate([zp[:, :-2], zp[:, 1:-1], zp[:, 2:]], axis=2)

    qb = jnp.pad(to_sub(q), ((0, 0), (0, Lp - L), (0, 0), (0, 0))).reshape(N, nb, half, H, Dh)
    kb = band(to_sub(k))
    vb = band(to_sub(v))

    qi = jnp.arange(half)[:, None]
    kj = jnp.arange(3 * half)[None, :]
    rel = kj - half - qi
    kpos = jnp.arange(nb)[:, None, None] * half + kj[None] - half
    valid = (jnp.abs(rel)[None] <= half) & (kpos >= 0) & (kpos < L)
    bias = -(slopes[:, None, None] * (dil * jnp.abs(rel)).astype(jnp.float32))

    s = jnp.einsum('nbqhd,nbkhd->nbhqk', qb, kb).astype(jnp.float32) + bias[None, None]
    s = jnp.where(valid[None, :, None], s, NEG_INF)
    m = jnp.max(s, axis=-1, keepdims=True)
    p = jnp.exp(s - m)
    l = jnp.sum(p, axis=-1)
    o = jnp.einsum('nbhqk,nbkhd->nbqhd', p.astype(vb.dtype), vb).astype(jnp.float32)
    o = o / jnp.swapaxes(l, 2, 3)[..., None]
    lse = jnp.swapaxes(m[..., 0] + jnp.log(l), 2, 3)

    def from_sub(z):
        tail = z.shape[3:]
        z = z.reshape(B, dil, Lp, *tail)[:, :, :L]
        return jnp.swapaxes(z, 1, 2).reshape(B, S, *tail)

    return from_sub(o), from_sub(lse)


def head_rmsnorm(z, g):
    z32 = z.astype(jnp.float32)
    return (z32 * lax.rsqrt(jnp.mean(z32 * z32, axis=-1, keepdims=True) + NORM_EPS) * g).astype(z.dtype)


def attention_mixer(p, q_norm_g, k_norm_g, attn_beta):
    B, S, _ = p.shape
    q, k, v = (z.reshape(B, S, ATTN_HEADS, HEAD_DIM) for z in jnp.split(p, 3, axis=-1))
    q = head_rmsnorm(q, q_norm_g) * (HEAD_DIM ** -0.5)
    k = head_rmsnorm(k, k_norm_g)
    slopes = alibi_slopes(ATTN_HEADS)
    outs, lses = [], []
    for window, dil in DILATION_PATTERNS:
        o, lse = dilated_band_attention(q, k, v, dil, window // (2 * dil), slopes)
        outs.append(o)
        lses.append(lse)
    wts = jax.nn.softmax(jnp.stack(lses), axis=0)
    o = jnp.sum(wts[..., None] * jnp.stack(outs), axis=0)
    return (o.reshape(B, S, ATTN_WIDTH) * attn_beta).astype(p.dtype)


def _rwkv_step(state, inp):
    w, kk, b, k, v, r = inp
    sa = jnp.einsum('dbhvk,dbhk->dbhv', state, kk)
    state = state * w[..., None, :] - sa[..., :, None] * b[..., None, :] + v[..., :, None] * k[..., None, :]
    y = jnp.einsum('dbhvk,dbhk->dbhv', state, r)
    return state, y


def rwkv7_mixer(p, mu_prev, mu_next, w0, w_up, a0, a_up, g_up, k_k, k_a, r_k, ln_x_w, ln_x_b):
    B, S, _ = p.shape
    f32 = jnp.float32
    prev = jnp.pad(p[:, :-1], ((0, 0), (1, 0), (0, 0)))
    nxt = jnp.pad(p[:, 1:], ((0, 0), (0, 1), (0, 0)))
    p = p + mu_prev * (prev - p) + mu_next * (nxt - p)
    cuts = tuple(int(c) for c in np.cumsum([RWKV_WIDTH] * 3 + [DECAY_RANK] * 2 + [ICLR_RANK] * 2))
    r, k, v, wd_f, wd_b, ad_f, ad_b, gd = jnp.split(p, cuts, axis=-1)
    wd = jnp.stack([wd_f, wd_b])
    ad = jnp.stack([ad_f, ad_b])
    w_raw = (w0[:, None, None] + jnp.einsum('dbsr,drc->dbsc', jnp.tanh(wd), w_up)).astype(f32)
    decay = jnp.exp(-jnp.exp(-jax.nn.softplus(-w_raw) - 0.5))
    a = jax.nn.sigmoid((a0[:, None, None] + jnp.einsum('dbsr,drc->dbsc', ad, a_up)).astype(f32))
    g = jax.nn.sigmoid(gd) @ g_up

    def heads(z):
        return z.reshape(*z.shape[:-1], RWKV_HEADS, HEAD_DIM)

    r32, k32, v32 = r.astype(f32), k.astype(f32), v.astype(f32)
    kk = heads(k32 * k_k)
    kk = kk * lax.rsqrt(jnp.maximum(jnp.sum(kk * kk, axis=-1, keepdims=True), 1e-24))
    kd = heads(k32[None] * (1.0 + (a - 1.0) * k_a))
    bd = kk[None] * heads(a)
    rh, vh = heads(r32), heads(v32)

    def both(z):
        return jnp.stack([z, jnp.flip(z, 1)])

    def dirs(z):
        return jnp.stack([z[0], jnp.flip(z[1], 1)])

    seqs = (dirs(heads(decay)), both(kk), dirs(bd), dirs(kd), both(vh), both(rh))
    seqs = tuple(jnp.moveaxis(z, 2, 0) for z in seqs)
    state0 = jnp.zeros((2, B, RWKV_HEADS, HEAD_DIM, HEAD_DIM), f32)
    _, ys = lax.scan(_rwkv_step, state0, seqs)
    ys = jnp.moveaxis(ys, 0, 2)
    y = ys[0] + jnp.flip(ys[1], 1)
    mu = jnp.mean(y, axis=-1, keepdims=True)
    var = jnp.mean(jnp.square(y - mu), axis=-1, keepdims=True)
    yn = ((y - mu) * lax.rsqrt(var + LN_X_EPS)).reshape(B, S, RWKV_WIDTH) * ln_x_w + ln_x_b
    bonus = jnp.sum(rh * (kd[0] + kd[1]) * r_k, axis=-1, keepdims=True) * vh
    out = (yn + bonus.reshape(B, S, RWKV_WIDTH)) * g
    return out.astype(p.dtype)


def encoder_layer(x, c, w_ada, b_ada, g_norm1, g_norm2, w_in, q_norm_g, k_norm_g, attn_beta,
                  mu_prev, mu_next, w0, w_up, a0, a_up, g_up, k_k, k_a, r_k, ln_x_w, ln_x_b,
                  w_out, w_ff1, w_ff2):
    mod = jax.nn.silu(c) @ w_ada + b_ada
    sh1, sc1, gt1, sh2, sc2, gt2 = (m[:, None, :] for m in jnp.split(mod, 6, axis=-1))
    h = rmsnorm(x, g_norm1) * (1.0 + sc1) + sh1
    p = h @ w_in
    attn = attention_mixer(p[..., :ATTN_IN], q_norm_g, k_norm_g, attn_beta)
    rw = rwkv7_mixer(p[..., ATTN_IN:], mu_prev, mu_next, w0, w_up, a0, a_up, g_up,
                     k_k, k_a, r_k, ln_x_w, ln_x_b)
    x = x + gt1 * (jnp.concatenate([attn, rw], axis=-1) @ w_out)
    h = rmsnorm(x, g_norm2) * (1.0 + sc2) + sh2
    x = x + gt2 * (jnp.square(jax.nn.relu(h @ w_ff1)) @ w_ff2)
    return x


def setup_inputs(seed: int = 0) -> dict:
    key = jax.random.key(seed)
    ks = jax.random.split(key, 32)
    f32 = jnp.float32
    L = DEPTH

    def nrm(k, shape, scale):
        return jax.random.normal(k, shape, f32) * scale

    return {
        'x_prompt': nrm(ks[0], (BATCH, SEQ, D_MODEL), 1.0),
        'x_sample': nrm(ks[1], (DEC_BATCH, DEC_SEQ, D_MODEL), 1.0),
        'c_prompt': nrm(ks[2], (BATCH, D_MODEL), 1.0),
        'c_sample': nrm(ks[3], (DEC_BATCH, D_MODEL), 1.0),
        'w_ada': nrm(ks[4], (L, D_MODEL, 6 * D_MODEL), 0.5 * D_MODEL ** -0.5),
        'b_ada': nrm(ks[5], (L, 6 * D_MODEL), 0.02),
        'g_norm1': 1.0 + nrm(ks[6], (L, D_MODEL), 0.02),
        'g_norm2': 1.0 + nrm(ks[7], (L, D_MODEL), 0.02),
        'w_in': nrm(ks[8], (L, D_MODEL, IN_WIDTH), D_MODEL ** -0.5),
        'q_norm_g': 1.0 + nrm(ks[9], (L, HEAD_DIM), 0.02),
        'k_norm_g': 1.0 + nrm(ks[10], (L, HEAD_DIM), 0.02),
        'attn_beta': 1.0 + nrm(ks[11], (L, ATTN_WIDTH), 0.02),
        'mu_prev': jax.random.uniform(ks[12], (L, RWKV_IN), f32, 0.0, 0.5),
        'mu_next': jax.random.uniform(ks[13], (L, RWKV_IN), f32, 0.0, 0.5),
        'w0': jax.random.uniform(ks[14], (L, 2, RWKV_WIDTH), f32, -5.0, 0.0),
        'w_up': nrm(ks[15], (L, 2, DECAY_RANK, RWKV_WIDTH), 0.1),
        'a0': nrm(ks[16], (L, 2, RWKV_WIDTH), 0.5),
        'a_up': nrm(ks[17], (L, 2, ICLR_RANK, RWKV_WIDTH), 0.1),
        'g_up': nrm(ks[18], (L, GATE_RANK, RWKV_WIDTH), GATE_RANK ** -0.5),
        'k_k': 0.85 + nrm(ks[19], (L, RWKV_WIDTH), 0.05),
        'k_a': 1.0 + nrm(ks[20], (L, RWKV_WIDTH), 0.05),
        'r_k': nrm(ks[21], (L, RWKV_HEADS, HEAD_DIM), 0.1),
        'ln_x_w': 1.0 + nrm(ks[22], (L, RWKV_WIDTH), 0.02),
        'ln_x_b': nrm(ks[23], (L, RWKV_WIDTH), 0.02),
        'w_out': nrm(ks[24], (L, D_MODEL, D_MODEL), D_MODEL ** -0.5),
        'w_ff1': nrm(ks[25], (L, D_MODEL, D_FF), D_MODEL ** -0.5),
        'w_ff2': nrm(ks[26], (L, D_FF, D_MODEL), 0.5 * D_FF ** -0.5),
    }


def reference(x_prompt, x_sample, c_prompt, c_sample, w_ada, b_ada, g_norm1, g_norm2, w_in,
              q_norm_g, k_norm_g, attn_beta, mu_prev, mu_next, w0, w_up, a0, a_up, g_up,
              k_k, k_a, r_k, ln_x_w, ln_x_b, w_out, w_ff1, w_ff2):
    y_prompt = x_prompt
    y_sample = x_sample
    for i in range(DEPTH):
        layer_params = (w_ada[i], b_ada[i], g_norm1[i], g_norm2[i], w_in[i], q_norm_g[i], k_norm_g[i],
                        attn_beta[i], mu_prev[i], mu_next[i], w0[i], w_up[i], a0[i], a_up[i], g_up[i],
                        k_k[i], k_a[i], r_k[i], ln_x_w[i], ln_x_b[i], w_out[i], w_ff1[i], w_ff2[i])
        y_prompt = encoder_layer(y_prompt, c_prompt, *layer_params)
        y_sample = encoder_layer(y_sample, c_sample, *layer_params)
    return (y_prompt, y_sample)
```

```cpp
#include <hip/hip_runtime.h>
#include <hip/hip_cooperative_groups.h>
#include <cstdio>
namespace cg = cooperative_groups;

#define LAS __attribute__((address_space(3)))
typedef unsigned short bf16_t;
typedef short bf16x8 __attribute__((ext_vector_type(8)));
typedef float f32x4 __attribute__((ext_vector_type(4)));
typedef float f32x2 __attribute__((ext_vector_type(2)));
typedef unsigned u32x4 __attribute__((ext_vector_type(4)));
typedef unsigned u32x2 __attribute__((ext_vector_type(2)));

constexpr int NTOK = 81920, NP = 16384, SS = 2048, DM = 1024, NSEQ = 33;
constexpr int NIN = 3456, NINP = 3584, DFF = 4096;
constexpr float NORM_EPS = 1e-6f, LNX_EPS = 64e-5f;
constexpr int LDS_BYTES = 131072 + 16;
constexpr int NPH = 12;

constexpr size_t OFF_WIN = 0;
constexpr size_t OFF_WOUT = OFF_WIN + (size_t)NINP * 1024 * 2;
constexpr size_t OFF_WFF1 = OFF_WOUT + (size_t)1024 * 1024 * 2;
constexpr size_t OFF_WFF2 = OFF_WFF1 + (size_t)4096 * 1024 * 2;
constexpr size_t OFF_WL = OFF_WFF2 + (size_t)1024 * 4096 * 2;
constexpr size_t OFF_MOD = OFF_WL + (size_t)2560 * 384 * 2;
constexpr size_t OFF_C = OFF_MOD + (size_t)NSEQ * 6144 * 4;
constexpr size_t OFF_H = OFF_C + (size_t)2 * NTOK * 8 * 4;
constexpr size_t OFF_PR = OFF_H + (size_t)NTOK * 1024 * 2;
constexpr size_t OFF_LORA = OFF_PR + (size_t)NTOK * 1920 * 2;
constexpr size_t OFF_Y = OFF_LORA + (size_t)NTOK * 2048 * 2;
constexpr size_t OFF_SUM = OFF_Y + (size_t)NTOK * 1024 * 2;
constexpr size_t OFF_FLAG = OFF_SUM + (size_t)16 * 64 * 32768;
constexpr size_t OFF_BAR = OFF_FLAG + 256;
constexpr size_t BAR_BYTES = 3456 * 4;
constexpr int XCD_BAR_WORDS_C = 3456;
constexpr size_t WS_END = OFF_BAR + 16384;
constexpr size_t OFF_X5 = OFF_Y;
constexpr size_t OFF_HID = OFF_PR;
static_assert(OFF_HID + (size_t)NTOK * 4096 * 2 <= WS_END, "hid fits");
constexpr size_t OUT_OFF_G = (size_t)NTOK * 1536 * 2;

struct Args {
    const float* in[27];
    float* out;
    unsigned char* ws;
    int ph_lo, ph_hi;
};
enum { I_XP = 0, I_XS, I_CP, I_CS, I_WADA, I_BADA, I_G1, I_G2, I_WIN, I_QG, I_KG, I_BETA, I_MUP, I_MUN, I_W0, I_WUP, I_A0, I_AUP, I_GUP, I_KK, I_KA, I_RK, I_LNW, I_LNB, I_WOUT, I_WFF1, I_WFF2 };

__device__ __forceinline__ float bf2f(bf16_t b) { return __uint_as_float(((unsigned)b) << 16); }
__device__ __forceinline__ bf16_t f2bf(float f) { unsigned u = __float_as_uint(f); u += 0x7FFFu + ((u >> 16) & 1u); return (bf16_t)(u >> 16); }
__device__ __forceinline__ unsigned cvt_pk_bf16(float lo, float hi) { unsigned r; asm volatile("v_cvt_pk_bf16_f32 %0, %1, %2" : "=v"(r) : "v"(lo), "v"(hi)); return r; }
__device__ __forceinline__ float lo_bf(unsigned u) { return __uint_as_float(u << 16); }
__device__ __forceinline__ float hi_bf(unsigned u) { return __uint_as_float(u & 0xffff0000u); }
template <int CTRL> __device__ __forceinline__ float dpp_mov(float x) { return __int_as_float(__builtin_amdgcn_update_dpp(0, __float_as_int(x), CTRL, 0xF, 0xF, true)); }
__device__ __forceinline__ float wave_sum(float v) {
    v += dpp_mov<0xB1>(v); v += dpp_mov<0x4E>(v); v += dpp_mov<0x141>(v); v += dpp_mov<0x140>(v);
    const float s0 = __int_as_float(__builtin_amdgcn_readlane(__float_as_int(v), 0)), s1 = __int_as_float(__builtin_amdgcn_readlane(__float_as_int(v), 16));
    const float s2 = __int_as_float(__builtin_amdgcn_readlane(__float_as_int(v), 32)), s3 = __int_as_float(__builtin_amdgcn_readlane(__float_as_int(v), 48));
    return (s0 + s1) + (s2 + s3);
}
__device__ __forceinline__ float wave_max(float v) {
#pragma unroll
    for (int o = 32; o >= 1; o >>= 1) v = fmaxf(v, __shfl_xor(v, o));
    return v;
}
__device__ __forceinline__ int seq_of_row(int row) { return row < NP ? 0 : 1 + (row - NP) / SS; }

namespace pg8 {
constexpr int BM = 256, BK = 64, HALF = 128, HTB = HALF * BK * 2, STAGE_BYTES = 8 * HTB, NXCD = 8, WGM = 8;
__device__ __forceinline__ int lds_byte(int r, int c) { const int st = (r >> 4) * 2 + (c >> 5), rr = r & 15, cc = c & 31, ob = rr * 64 + cc * 2; return st * 1024 + (ob ^ (((ob >> 9) & 1) << 5)); }
__device__ __forceinline__ void stage_rc(int b, int& R, int& C) { const int st = b / 1024, sb = b % 1024, swz = sb ^ (((sb >> 9) & 1) << 5); R = (st >> 1) * 16 + swz / 64; C = (st & 1) * 32 + (swz % 64) / 2; }
__device__ __forceinline__ int perm32(int rho) { const int n = rho >> 4, i = rho & 15; return 8 * (i >> 2) + 4 * n + (i & 3); }
struct Unit { int pm, pn; };
struct Gemm { const bf16_t* A; const bf16_t* Bt; int M, N, K; };
struct StaticOrder {
    int nM, nN, nwg, G, c;
    __device__ void init(int M, int N, int G_, int c_) { nM = M / BM; nN = N / BM; nwg = nM * nN; G = G_; c = c_; }
    __device__ bool next(int i, Unit& u) const {
        const long L = (long)i * G + c; if (L >= nwg) return false;
        int wgid = (int)L; { const int q = nwg / NXCD, r = nwg % NXCD, xcd = wgid % NXCD, off = wgid / NXCD; wgid = (xcd < r ? xcd * (q + 1) : r * (q + 1) + (xcd - r) * q) + off; }
        const int nig = WGM * nN, gid = wgid / nig, fm = gid * WGM, gsz = (nM - fm) < WGM ? (nM - fm) : WGM;
        u.pm = fm + ((wgid % nig) % gsz); u.pn = (wgid % nig) / gsz; return true;
    }
};

template <class Epi>
__device__ __forceinline__ void gemm_phase(LAS unsigned char* lds, const Gemm g, const StaticOrder& S, const Epi& E) {
    const int tid = threadIdx.x, wid = __builtin_amdgcn_readfirstlane(tid >> 6), lane = tid & 63, wr = wid >> 2, wc = wid & 3, fr = lane & 15, fq = lane >> 4;
    const int K = g.K, nt = K / BK;
    unsigned voffA[2], voffB[2];
#pragma unroll
    for (int i = 0; i < 2; ++i) { int R, C; stage_rc(tid * 16 + i * 8192, R, C); const int Rb = Epi::PERM ? ((R & ~31) + perm32(R & 31)) : R;
        const int Rh = 64 * (R >> 5) + perm32(R & 31);
        voffA[i] = (unsigned)(R * K + C) * 2u; voffB[i] = (unsigned)((Epi::HEADMAP ? Rh : Rb) * K + C) * 2u; }
    const size_t kstep = (size_t)(BK * 2);
    const size_t hstep = (size_t)HALF * K * 2;
    const size_t tstep = 2 * hstep;
    const size_t hstepB = Epi::HEADMAP ? (size_t)32 * K * 2 : hstep;
    const unsigned ldsw = (unsigned)wid * 1024u;
    const int aoff = lds_byte(wr * 64 + fr, fq * 8), boff = lds_byte(wc * 32 + fr, fq * 8);
#define PG8_SA(b, h) (((b) * 2 + (h)) * HTB)
#define PG8_SB(b, h) ((4 + (b) * 2 + (h)) * HTB)
#define PG8_STAGE(bufoff, gbase, voff) do { _Pragma("unroll") for (int _i = 0; _i < 2; ++_i) \
        __builtin_amdgcn_global_load_lds((const unsigned*)((const char*)(gbase) + (voff)[_i]), (LAS unsigned*)(lds + (bufoff) + ldsw + _i * 8192), 16, 0, 0); } while (0)
#define PG8_LDA(dst, b, h) do { _Pragma("unroll") for (int m = 0; m < 4; ++m) _Pragma("unroll") for (int k = 0; k < 2; ++k) dst[m][k] = *(const LAS bf16x8*)(lds + PG8_SA(b, h) + aoff + m * 2048 + k * 1024); } while (0)
#define PG8_LDB(dst, b, h) do { _Pragma("unroll") for (int n = 0; n < 2; ++n) _Pragma("unroll") for (int k = 0; k < 2; ++k) dst[n][k] = *(const LAS bf16x8*)(lds + PG8_SB(b, h) + boff + n * 2048 + k * 1024); } while (0)
#define PG8_MMA(ai, bj, At, Bt) do { __builtin_amdgcn_s_setprio(1); _Pragma("unroll") for (int m = 0; m < 4; ++m) _Pragma("unroll") for (int n = 0; n < 2; ++n) _Pragma("unroll") for (int k = 0; k < 2; ++k) \
        acc[ai][bj][m][n] = __builtin_amdgcn_mfma_f32_16x16x32_bf16(Bt[n][k], At[m][k], acc[ai][bj][m][n], 0, 0, 0); __builtin_amdgcn_s_setprio(0); } while (0)
#define PG8_WAIT_V(n) asm volatile("s_waitcnt vmcnt(" #n ")" ::: "memory")
#define PG8_WAIT_L(n) asm volatile("s_waitcnt lgkmcnt(" #n ")" ::: "memory")
#define PG8_BAR __builtin_amdgcn_s_barrier()
#define PG8_SCHED __builtin_amdgcn_sched_barrier(0)
    Unit cur, nxt; int ui = 0;
    if (!S.next(0, cur)) return;
    f32x4 acc[2][2][4][2];
#pragma unroll
    for (int a = 0; a < 2; ++a)
#pragma unroll
        for (int b = 0; b < 2; ++b)
#pragma unroll
            for (int m = 0; m < 4; ++m)
#pragma unroll
                for (int n = 0; n < 2; ++n) acc[a][b][m][n] = (f32x4){0.f, 0.f, 0.f, 0.f};
    bf16x8 At[4][2], B0[2][2], B1[2][2];
    const char* cA = (const char*)g.A + (size_t)cur.pm * tstep; const char* cB = (const char*)g.Bt + (size_t)cur.pn * tstep;
    PG8_STAGE(PG8_SB(0, 0), cB, voffB); PG8_STAGE(PG8_SA(0, 0), cA, voffA); PG8_STAGE(PG8_SB(0, 1), cB + hstepB, voffB); PG8_STAGE(PG8_SA(0, 1), cA + hstep, voffA);
    if (wr == 1) PG8_BAR;
    PG8_WAIT_V(4); PG8_BAR;
    PG8_STAGE(PG8_SB(1, 0), cB + kstep, voffB); PG8_STAGE(PG8_SA(1, 0), cA + kstep, voffA); PG8_STAGE(PG8_SB(1, 1), cB + hstepB + kstep, voffB);
    PG8_WAIT_V(6); PG8_BAR;
    for (;;) {
        const bool has_next = S.next(ui + 1, nxt);
        const char* nA = has_next ? (const char*)g.A + (size_t)nxt.pm * tstep : cA; const char* nB = has_next ? (const char*)g.Bt + (size_t)nxt.pn * tstep : cB;
#pragma unroll 1
        for (int t = 0; t < nt; t += 2) {
            const bool last = (t == nt - 2);
            const char* a1 = cA + (size_t)(t + 1) * kstep;
            const char* a2 = last ? nA : cA + (size_t)(t + 2) * kstep; const char* b2 = last ? nB : cB + (size_t)(t + 2) * kstep;
            const char* a3 = a2 + kstep; const char* b3 = b2 + kstep;
            PG8_LDB(B0, 0, 0); PG8_SCHED; PG8_LDA(At, 0, 0); PG8_STAGE(PG8_SA(1, 1), a1 + hstep, voffA);
            PG8_WAIT_L(8); PG8_BAR; PG8_WAIT_L(0); PG8_MMA(0, 0, At, B0); PG8_BAR; PG8_SCHED;
            PG8_LDB(B1, 0, 1); PG8_STAGE(PG8_SB(0, 0), b2, voffB);
            PG8_BAR; PG8_WAIT_L(0); PG8_MMA(0, 1, At, B1); PG8_BAR;
            PG8_LDA(At, 0, 1); PG8_STAGE(PG8_SA(0, 0), a2, voffA);
            PG8_BAR; PG8_WAIT_L(0); PG8_MMA(1, 0, At, B0); PG8_BAR; PG8_SCHED;
            PG8_STAGE(PG8_SB(0, 1), b2 + hstepB, voffB);
            PG8_WAIT_V(6); PG8_BAR; PG8_MMA(1, 1, At, B1); PG8_BAR;
            PG8_LDB(B0, 1, 0); PG8_SCHED; PG8_LDA(At, 1, 0); PG8_STAGE(PG8_SA(0, 1), a2 + hstep, voffA);
            PG8_WAIT_L(8); PG8_BAR; PG8_WAIT_L(0); PG8_MMA(0, 0, At, B0); PG8_BAR; PG8_SCHED;
            PG8_LDB(B1, 1, 1); PG8_STAGE(PG8_SB(1, 0), b3, voffB);
            PG8_BAR; PG8_WAIT_L(0); PG8_MMA(0, 1, At, B1); PG8_BAR;
            PG8_LDA(At, 1, 1); PG8_STAGE(PG8_SA(1, 0), a3, voffA);
            PG8_BAR; PG8_WAIT_L(0); PG8_MMA(1, 0, At, B0); PG8_BAR; PG8_SCHED;
            PG8_STAGE(PG8_SB(1, 1), b3 + hstepB, voffB);
            PG8_WAIT_V(6); PG8_BAR; PG8_MMA(1, 1, At, B1); PG8_BAR;
        }
        E(acc, cur, wr, wc, fr, fq);
        if (!has_next) break;
#pragma unroll
        for (int a = 0; a < 2; ++a)
#pragma unroll
            for (int b = 0; b < 2; ++b)
#pragma unroll
                for (int m = 0; m < 4; ++m)
#pragma unroll
                    for (int n = 0; n < 2; ++n) acc[a][b][m][n] = (f32x4){0.f, 0.f, 0.f, 0.f};
        cur = nxt; cA = nA; cB = nB; ++ui;
    }
    PG8_WAIT_V(0);
    if (wr == 0) PG8_BAR;
    PG8_BAR;
#undef PG8_SA
#undef PG8_SB
#undef PG8_STAGE
#undef PG8_LDA
#undef PG8_LDB
#undef PG8_MMA
#undef PG8_WAIT_V
#undef PG8_WAIT_L
#undef PG8_BAR
#undef PG8_SCHED
}
}
using pg8::Unit;
typedef f32x4 AccT[2][2][4][2];

struct EpiIn {
    static constexpr bool PERM = true, HEADMAP = true;
    bf16_t* QKV; bf16_t* PR; const float* qg; const float* kg;
    __device__ __forceinline__ void operator()(const AccT& acc, const Unit& u, int wr, int wc, int fr, int fq) const {
        const int row0 = u.pm * 256 + wr * 64 + fr;
        bf16_t* base; int ldc, colt, lim;
        if (u.pn < 6) { base = QKV; ldc = 1536; colt = u.pn * 256; lim = 1536; } else { base = PR; ldc = 1920; colt = (u.pn - 6) * 256; lim = 1920; }
        const int col0 = colt + wc * 64 + 8 * fq;
        const bool nrm = u.pn < 4;
        f32x4 g4[2][2];
        if (nrm) { const float* gp = (u.pn < 2 ? qg : kg) + 8 * fq;
#pragma unroll
            for (int bj = 0; bj < 2; ++bj)
#pragma unroll
                for (int n = 0; n < 2; ++n) g4[bj][n] = *(const f32x4*)(gp + 32 * bj + 4 * n); }
        const float qs = u.pn < 2 ? 0.125f : 1.f;
#pragma unroll
        for (int ai = 0; ai < 2; ++ai)
#pragma unroll
            for (int m = 0; m < 4; ++m) { bf16_t* rowp = base + (size_t)(row0 + ai * 128 + m * 16) * ldc + col0;
                f32x4 v[2][2];
#pragma unroll
                for (int bj = 0; bj < 2; ++bj)
#pragma unroll
                    for (int n = 0; n < 2; ++n) v[bj][n] = acc[ai][bj][m][n];
                if (nrm) {
                    float ss = 0.f;
#pragma unroll
                    for (int bj = 0; bj < 2; ++bj)
#pragma unroll
                        for (int n = 0; n < 2; ++n) ss += v[bj][n][0] * v[bj][n][0] + v[bj][n][1] * v[bj][n][1] + v[bj][n][2] * v[bj][n][2] + v[bj][n][3] * v[bj][n][3];
                    ss += __shfl_xor(ss, 16); ss += __shfl_xor(ss, 32);
                    const float sc = rsqrtf(ss * (1.f / 64.f) + NORM_EPS) * qs;
#pragma unroll
                    for (int bj = 0; bj < 2; ++bj)
#pragma unroll
                        for (int n = 0; n < 2; ++n) v[bj][n] = v[bj][n] * sc * g4[bj][n];
                }
#pragma unroll
                for (int bj = 0; bj < 2; ++bj) {
                    u32x4 w; w.x = cvt_pk_bf16(v[bj][0][0], v[bj][0][1]); w.y = cvt_pk_bf16(v[bj][0][2], v[bj][0][3]); w.z = cvt_pk_bf16(v[bj][1][0], v[bj][1][1]); w.w = cvt_pk_bf16(v[bj][1][2], v[bj][1][3]);
                    if (col0 + bj * 32 < lim) *(u32x4*)(rowp + bj * 32) = w; } }
    }
};
struct EpiLora {
    static constexpr bool PERM = true, HEADMAP = false;
    bf16_t* LORA; bf16_t* G; const float* w0; const float* a0;
    __device__ __forceinline__ void operator()(const AccT& acc, const Unit& u, int wr, int wc, int fr, int fq) const {
        const int row0 = u.pm * 256 + wr * 64 + fr;
        bf16_t* base; int ldc, colt; const bool isg = u.pn >= 8;
        if (!isg) { base = LORA; ldc = 2048; colt = u.pn * 256; } else { base = G; ldc = 512; colt = (u.pn - 8) * 256; }
        const int col0 = colt + wc * 32 + 8 * fq;
#pragma unroll
        for (int bj = 0; bj < 2; ++bj) {
#pragma unroll
            for (int ai = 0; ai < 2; ++ai)
#pragma unroll
                for (int m = 0; m < 4; ++m) { bf16_t* rowp = base + (size_t)(row0 + ai * 128 + m * 16) * ldc + col0 + bj * 128;
                    const f32x4 v0 = acc[ai][bj][m][0], v1 = acc[ai][bj][m][1];
                    u32x4 w; w.x = cvt_pk_bf16(v0[0], v0[1]); w.y = cvt_pk_bf16(v0[2], v0[3]); w.z = cvt_pk_bf16(v1[0], v1[1]); w.w = cvt_pk_bf16(v1[2], v1[3]);
                    *(u32x4*)rowp = w; }
        }
    }
};
struct EpiFf1 {
    static constexpr bool PERM = true, HEADMAP = false;
    bf16_t* HID;
    __device__ __forceinline__ void operator()(const AccT& acc, const Unit& u, int wr, int wc, int fr, int fq) const {
        const int row0 = u.pm * 256 + wr * 64 + fr;
        const int col0 = u.pn * 256 + wc * 32 + 8 * fq;
#pragma unroll
        for (int ai = 0; ai < 2; ++ai)
#pragma unroll
            for (int m = 0; m < 4; ++m) { bf16_t* rowp = HID + (size_t)(row0 + ai * 128 + m * 16) * DFF + col0;
#pragma unroll
                for (int bj = 0; bj < 2; ++bj) { f32x4 v0 = acc[ai][bj][m][0], v1 = acc[ai][bj][m][1];
#pragma unroll
                    for (int j = 0; j < 4; ++j) { const float a = fmaxf(v0[j], 0.f), b = fmaxf(v1[j], 0.f); v0[j] = a * a; v1[j] = b * b; }
                    u32x4 w; w.x = cvt_pk_bf16(v0[0], v0[1]); w.y = cvt_pk_bf16(v0[2], v0[3]); w.z = cvt_pk_bf16(v1[0], v1[1]); w.w = cvt_pk_bf16(v1[2], v1[3]);
                    *(u32x4*)(rowp + bj * 128) = w; } }
    }
};
struct EpiRes {
    static constexpr bool PERM = false, HEADMAP = false;
    float* out; const float* xp; const float* xs; const float* mod; int gate_off;
    __device__ __forceinline__ void operator()(const AccT& acc, const Unit& u, int wr, int wc, int fr, int fq) const {
        const int row0 = u.pm * 256 + wr * 64 + fr, col0 = u.pn * 256 + wc * 32 + 4 * fq;
        const int sq = seq_of_row(u.pm * 256);
        const float* gp = mod + (size_t)sq * 6144 + gate_off + col0;
        f32x4 gv[2][2];
#pragma unroll
        for (int bj = 0; bj < 2; ++bj)
#pragma unroll
            for (int n = 0; n < 2; ++n) gv[bj][n] = *(const f32x4*)(gp + bj * 128 + n * 16);
#pragma unroll
        for (int ai = 0; ai < 2; ++ai)
#pragma unroll
            for (int m = 0; m < 4; ++m) { const int row = row0 + ai * 128 + m * 16;
                float* op = out + (size_t)row * DM + col0;
                const float* rp = xp ? (row < NP ? xp + (size_t)row * DM : xs + (size_t)(row - NP) * DM) + col0 : op;
#pragma unroll
                for (int bj = 0; bj < 2; ++bj)
#pragma unroll
                    for (int n = 0; n < 2; ++n) { const f32x4 r = *(const f32x4*)(rp + bj * 128 + n * 16);
                        *(f32x4*)(op + bj * 128 + n * 16) = r + gv[bj][n] * acc[ai][bj][m][n]; } }
    }
};

__device__ void xpose_tile(LAS float* tile, const float* W, int N, int K, int k0, int n0, bf16_t* Wt) {
    const int tid = threadIdx.x;
#pragma unroll
    for (int i = 0; i < 8; ++i) { const int kk = (tid >> 6) + 8 * i, nn = tid & 63; tile[kk * 65 + nn] = W[(size_t)(k0 + kk) * N + n0 + nn]; }
    __syncthreads();
#pragma unroll
    for (int i = 0; i < 8; ++i) { const int nn = (tid >> 6) + 8 * i, kk = tid & 63; Wt[(size_t)(n0 + nn) * K + k0 + kk] = f2bf(tile[kk * 65 + nn]); }
    __syncthreads();
}
__device__ void phase_prep_weights(const Args& a, LAS unsigned char* lds) {
    LAS float* tile = (LAS float*)lds;
    bf16_t* WIN = (bf16_t*)(a.ws + OFF_WIN); bf16_t* WOUT = (bf16_t*)(a.ws + OFF_WOUT); bf16_t* WFF1 = (bf16_t*)(a.ws + OFF_WFF1); bf16_t* WFF2 = (bf16_t*)(a.ws + OFF_WFF2); bf16_t* WL = (bf16_t*)(a.ws + OFF_WL);
    for (int t = blockIdx.x; t < 3168; t += gridDim.x) {
        if (t < 864) { const int kt = t / 54, ntl = t % 54; xpose_tile(tile, a.in[I_WIN], NIN, 1024, kt * 64, ntl * 64, WIN); }
        else if (t < 1120) { const int u = t - 864; xpose_tile(tile, a.in[I_WOUT], 1024, 1024, (u / 16) * 64, (u % 16) * 64, WOUT); }
        else if (t < 2144) { const int u = t - 1120; xpose_tile(tile, a.in[I_WFF1], 4096, 1024, (u / 64) * 64, (u % 64) * 64, WFF1); }
        else { const int u = t - 2144; xpose_tile(tile, a.in[I_WFF2], 1024, 4096, (u / 16) * 64, (u % 16) * 64, WFF2); }
    }
    const int gtid = blockIdx.x * 512 + threadIdx.x, gn = gridDim.x * 512;
    if (gtid < 64) ((int*)(a.ws + OFF_FLAG))[gtid] = 0;
    if (gtid < XCD_BAR_WORDS_C) ((unsigned*)(a.ws + OFF_BAR))[gtid] = 0u;
    for (int i = gtid; i < 128 * 1024; i += gn) WIN[(size_t)NIN * 1024 + i] = 0;
    for (int i = gtid; i < 2560 * 384; i += gn) {
        const int n = i / 384, kc = i % 384; float v = 0.f;
        if (n < 512) { if (kc < 64) v = a.in[I_WUP][(size_t)(0 * 64 + kc) * 512 + n]; }
        else if (n < 1024) { if (kc >= 64 && kc < 128) v = a.in[I_WUP][(size_t)(1 * 64 + kc - 64) * 512 + (n - 512)]; }
        else if (n < 1536) { if (kc >= 128 && kc < 192) v = a.in[I_AUP][(size_t)(0 * 64 + kc - 128) * 512 + (n - 1024)]; }
        else if (n < 2048) { if (kc >= 192 && kc < 256) v = a.in[I_AUP][(size_t)(1 * 64 + kc - 192) * 512 + (n - 1536)]; }
        else { if (kc >= 256) v = a.in[I_GUP][(size_t)(kc - 256) * 512 + (n - 2048)]; }
        WL[i] = f2bf(v);
    }
}
__device__ void phase_mod(const Args& a, LAS unsigned char* lds) {
    float* MOD = (float*)(a.ws + OFF_MOD);
    const int wave = threadIdx.x >> 6, lane = threadIdx.x & 63;
    LAS float* sl = (LAS float*)lds + wave * (64 * 36);
    for (int it = blockIdx.x; it < 96; it += gridDim.x) {
        const int j0 = it * 64;
        float acc[36];
#pragma unroll
        for (int b = 0; b < 36; ++b) acc[b] = 0.f;
        for (int half = 0; half < 2; ++half) {
            const int k0 = wave * 128 + half * 64;
#pragma unroll 1
            for (int b = 0; b < 36; ++b) { float sv = 0.f;
                if (b < NSEQ) { const float c = (b == 0) ? a.in[I_CP][k0 + lane] : a.in[I_CS][(size_t)(b - 1) * DM + k0 + lane]; sv = c / (1.f + __expf(-c)); }
                sl[lane * 36 + b] = sv; }
            asm volatile("s_waitcnt lgkmcnt(0)" ::: "memory");
#pragma unroll 1
            for (int k = 0; k < 64; ++k) { const float wv = a.in[I_WADA][(size_t)(k0 + k) * 6144 + j0 + lane];
                const LAS f32x4* sp = (const LAS f32x4*)(sl + k * 36);
#pragma unroll
                for (int q = 0; q < 9; ++q) { const f32x4 s4 = sp[q]; acc[4 * q] += s4[0] * wv; acc[4 * q + 1] += s4[1] * wv; acc[4 * q + 2] += s4[2] * wv; acc[4 * q + 3] += s4[3] * wv; } }
            asm volatile("s_waitcnt lgkmcnt(0)" ::: "memory");
        }
        __syncthreads();
        LAS float* ex = (LAS float*)lds;
#pragma unroll
        for (int b = 0; b < NSEQ; ++b) ex[wave * (NSEQ * 64) + b * 64 + lane] = acc[b];
        __syncthreads();
        for (int idx = threadIdx.x; idx < NSEQ * 64; idx += 512) { float sm = a.in[I_BADA][j0 + (idx & 63)];
#pragma unroll
            for (int w = 0; w < 8; ++w) sm += ex[w * (NSEQ * 64) + idx];
            MOD[(size_t)(idx >> 6) * 6144 + j0 + (idx & 63)] = sm; }
        __syncthreads();
    }
}

__device__ void phase_norm(const Args& a, const float* xp, const float* xs, const float* g, int sh_off, int sc_off) {
    const float* MOD = (const float*)(a.ws + OFF_MOD); bf16_t* H = (bf16_t*)(a.ws + OFF_H);
    const int wave = threadIdx.x >> 6, lane = threadIdx.x & 63;
    for (int row = blockIdx.x * 8 + wave; row < NTOK; row += gridDim.x * 8) {
        const float* xr = (row < NP) ? xp + (size_t)row * DM : xs + (size_t)(row - NP) * DM;
        const float* mr = MOD + (size_t)seq_of_row(row) * 6144;
        f32x4 v[4]; float ss = 0.f;
#pragma unroll
        for (int i = 0; i < 4; ++i) { v[i] = *(const f32x4*)(xr + i * 256 + lane * 4); ss += v[i][0] * v[i][0] + v[i][1] * v[i][1] + v[i][2] * v[i][2] + v[i][3] * v[i][3]; }
        ss = wave_sum(ss);
        const float rinv = rsqrtf(ss * (1.f / DM) + NORM_EPS);
#pragma unroll
        for (int i = 0; i < 4; ++i) { const int c = i * 256 + lane * 4;
            const f32x4 gg = *(const f32x4*)(g + c), sc = *(const f32x4*)(mr + sc_off + c), sh = *(const f32x4*)(mr + sh_off + c);
            f32x4 h;
#pragma unroll
            for (int j = 0; j < 4; ++j) h[j] = v[i][j] * rinv * gg[j] * (1.f + sc[j]) + sh[j];
            u32x2 w; w.x = cvt_pk_bf16(h[0], h[1]); w.y = cvt_pk_bf16(h[2], h[3]);
            *(u32x2*)(H + (size_t)row * DM + c) = w; }
    }
}

__device__ void phase_post_in(const Args& a) {
    const bf16_t* PR = (const bf16_t*)(a.ws + OFF_PR); bf16_t* X5 = (bf16_t*)(a.ws + OFF_X5);
    const int wave = threadIdx.x >> 6, lane = threadIdx.x & 63;
    const int c0 = (lane < 48 ? lane : 0) * 8;
    float mp[8], mn[8];
#pragma unroll
    for (int j = 0; j < 8; ++j) { mp[j] = a.in[I_MUP][1536 + c0 + j]; mn[j] = a.in[I_MUN][1536 + c0 + j]; }
    const int nw = gridDim.x * 8;
    for (int row = blockIdx.x * 8 + wave; row < NTOK; row += 2 * nw) {
        const int row2 = (row + nw < NTOK) ? row + nw : row;
        u32x4 cu[2], pv[2], nx[2]; int rr[2]; rr[0] = row; rr[1] = row2;
#pragma unroll
        for (int q = 0; q < 2; ++q) { const int r = rr[q];
            int pos, S; if (r < NP) { pos = r; S = NP; } else { pos = (r - NP) % SS; S = SS; }
            const bf16_t* pr = PR + (size_t)r * 1920 + 1536 + c0;
            cu[q] = *(const u32x4*)pr;
            pv[q] = pos > 0 ? *(const u32x4*)(pr - 1920) : (u32x4){0u, 0u, 0u, 0u};
            nx[q] = pos < S - 1 ? *(const u32x4*)(pr + 1920) : (u32x4){0u, 0u, 0u, 0u}; }
#pragma unroll
        for (int q = 0; q < 2; ++q) {
            if (q == 1 && row2 == row) break;
            float x[8];
#pragma unroll
            for (int j = 0; j < 4; ++j) { const float c_lo = lo_bf(cu[q][j]), c_hi = hi_bf(cu[q][j]);
                x[2 * j] = c_lo + mp[2 * j] * (lo_bf(pv[q][j]) - c_lo) + mn[2 * j] * (lo_bf(nx[q][j]) - c_lo);
                x[2 * j + 1] = c_hi + mp[2 * j + 1] * (hi_bf(pv[q][j]) - c_hi) + mn[2 * j + 1] * (hi_bf(nx[q][j]) - c_hi); }
            if (lane < 16) {
#pragma unroll
                for (int j = 0; j < 8; ++j) x[j] = tanhf(x[j]);
            } else if (lane >= 32) {
#pragma unroll
                for (int j = 0; j < 8; ++j) x[j] = 1.f / (1.f + __expf(-x[j]));
            }
            u32x4 w; w.x = cvt_pk_bf16(x[0], x[1]); w.y = cvt_pk_bf16(x[2], x[3]); w.z = cvt_pk_bf16(x[4], x[5]); w.w = cvt_pk_bf16(x[6], x[7]);
            if (lane < 48) *(u32x4*)(X5 + (size_t)rr[q] * 384 + c0) = w;
        }
    }
}

__device__ void attn_job4(const Args& a, LAS bf16_t* vlb, int row0, int S, int h, int q0a, float cshift) {
    const bf16_t* QKV = (const bf16_t*)a.out; bf16_t* MIX = (bf16_t*)(a.ws + OFF_H);
    const int lane = threadIdx.x & 63, fr = lane & 15, g = lane >> 4;
    const float slope = exp2f(-(float)(h + 1));
    constexpr int VP = 64;
    const bf16_t* kbase = QKV + (size_t)row0 * 1536 + 512 + h * 64 + g * 8;
    const bf16_t* vbase = QKV + (size_t)row0 * 1536 + 1024 + h * 64;
    int qp[4]; f32x4 O[4][4]; float l[4];
    LAS bf16x8* qlds = (LAS bf16x8*)(vlb + 2 * 32 * VP);
    asm volatile("s_waitcnt lgkmcnt(0)" ::: "memory");
#pragma unroll
    for (int jj = 0; jj < 4; ++jj) { qp[jj] = q0a + 4 * jj + 16 * fr;
        const bf16_t* qrow = QKV + (size_t)(row0 + qp[jj]) * 1536 + h * 64;
        qlds[(jj * 2 + 0) * 64 + lane] = *(const bf16x8*)(qrow + g * 8); qlds[(jj * 2 + 1) * 64 + lane] = *(const bf16x8*)(qrow + 32 + g * 8); l[jj] = 0.f;
#pragma unroll
        for (int i = 0; i < 4; ++i) O[jj][i] = (f32x4){0.f, 0.f, 0.f, 0.f}; }
    bf16x8 nka0[2], nka1[2], nkb0[2], nkb1[2]; u32x4 nvv[2][4];
    const float slope2 = slope * 1.44269504f, c2 = cshift * 1.44269504f;
    const unsigned traddr = (unsigned)(unsigned long)vlb + (unsigned)((8 * g + ((lane & 15) >> 2)) * (VP * 2) + 8 * (lane & 3));
#define LOAD_SET(KJ, Q0S, D_, TP_) { const int base_ = (Q0S) - 64 * (D_); \
        int kpa = base_ + (D_) * (16 * (TP_) + fr), kpb = kpa + 16 * (D_); kpa = min(max(kpa, 0), S - 1); kpb = min(max(kpb, 0), S - 1); \
        const bf16_t* ka = kbase + (size_t)kpa * 1536; const bf16_t* kb = kbase + (size_t)kpb * 1536; \
        nka0[KJ] = *(const bf16x8*)ka; nka1[KJ] = *(const bf16x8*)(ka + 32); nkb0[KJ] = *(const bf16x8*)kb; nkb1[KJ] = *(const bf16x8*)(kb + 32); \
        _Pragma("unroll") for (int i = 0; i < 4; ++i) { const int idx = lane + 64 * i, rr = idx >> 3, chk = idx & 7; \
            int kp = base_ + (D_) * (16 * (TP_) + rr); kp = min(max(kp, 0), S - 1); nvv[KJ][i] = *(const u32x4*)(vbase + (size_t)kp * 1536 + chk * 8); } }
#define V_TO_LDS(KJ) _Pragma("unroll") for (int i = 0; i < 4; ++i) { const int idx = lane + 64 * i, rr = idx >> 3, chk = idx & 7; \
            const int rho = 8 * ((rr & 15) >> 2) + 4 * (rr >> 4) + (rr & 3); \
            *(LAS u32x4*)(vlb + (KJ) * (32 * VP) + rho * VP + chk * 8) = nvv[KJ][i]; }
#define QK_SOFTMAX(JJ, KJ, SHIFT, D_, TP_, PF) { \
        const bf16x8 q0_ = qlds[((JJ) * 2 + 0) * 64 + lane], q1_ = qlds[((JJ) * 2 + 1) * 64 + lane]; \
        f32x4 sa_ = __builtin_amdgcn_mfma_f32_16x16x32_bf16(nka0[KJ], q0_, (f32x4){0.f, 0.f, 0.f, 0.f}, 0, 0, 0); sa_ = __builtin_amdgcn_mfma_f32_16x16x32_bf16(nka1[KJ], q1_, sa_, 0, 0, 0); \
        f32x4 sb_ = __builtin_amdgcn_mfma_f32_16x16x32_bf16(nkb0[KJ], q0_, (f32x4){0.f, 0.f, 0.f, 0.f}, 0, 0, 0); sb_ = __builtin_amdgcn_mfma_f32_16x16x32_bf16(nkb1[KJ], q1_, sb_, 0, 0, 0); \
        const float fd_ = (float)(D_); \
        const float fR0 = (float)((D_) * (16 * (TP_) + 4 * g - 64) - 16 * fr) - (float)(SHIFT); \
        const float lo = fmaxf(-64.f * fd_, -(float)qp[JJ]), hi = fminf(64.f * fd_, (float)(S - 1 - qp[JJ])); \
        float pa[4], pb[4]; \
        _Pragma("unroll") for (int j = 0; j < 4; ++j) { \
            const float r1 = fR0 + (float)j * fd_, r2 = r1 + 16.f * fd_; \
            const float e1 = __builtin_amdgcn_exp2f(__builtin_fmaf(-slope2, fabsf(r1), __builtin_fmaf(sa_[j], 1.44269504f, -c2))); \
            const float e2 = __builtin_amdgcn_exp2f(__builtin_fmaf(-slope2, fabsf(r2), __builtin_fmaf(sb_[j], 1.44269504f, -c2))); \
            pa[j] = (r1 >= lo && r1 <= hi) ? e1 : 0.f; pb[j] = (r2 >= lo && r2 <= hi) ? e2 : 0.f; \
            l[JJ] += pa[j] + pb[j]; } \
        u32x4 pw; pw.x = cvt_pk_bf16(pa[0], pa[1]); pw.y = cvt_pk_bf16(pa[2], pa[3]); pw.z = cvt_pk_bf16(pb[0], pb[1]); pw.w = cvt_pk_bf16(pb[2], pb[3]); \
        __builtin_memcpy(&PF, &pw, 16); }
#define TR_READ2(KJ, DB0, TV) { _Pragma("unroll") for (int db = 0; db < 2; ++db) _Pragma("unroll") for (int t = 0; t < 2; ++t) \
            asm volatile("ds_read_b64_tr_b16 %0, %1" : "=v"(TV[db][t]) : "v"(traddr + (unsigned)((KJ) * (32 * VP * 2) + t * (4 * VP * 2) + ((DB0) + db) * 32))); \
        asm volatile("s_waitcnt lgkmcnt(0)" : "+v"(TV[0][0]), "+v"(TV[0][1]), "+v"(TV[1][0]), "+v"(TV[1][1]) :: "memory"); }
#define PV2(JJ, DB0, TV, PF) _Pragma("unroll") for (int db = 0; db < 2; ++db) { \
            u32x4 vw; vw.x = TV[db][0].x; vw.y = TV[db][0].y; vw.z = TV[db][1].x; vw.w = TV[db][1].y; \
            bf16x8 vf; __builtin_memcpy(&vf, &vw, 16); \
            O[JJ][(DB0) + db] = __builtin_amdgcn_mfma_f32_16x16x32_bf16(vf, PF, O[JJ][(DB0) + db], 0, 0, 0); }
    LOAD_SET(0, q0a, 1, 0)
    for (int st = 0; st < 18; ++st) {
        const int d = st < 12 ? 1 : 4, tp = st < 12 ? 2 * st : 2 * (st - 12);
        bf16x8 pf0, pf1, pf2, pf3;
        QK_SOFTMAX(0, 0, 0, d, tp, pf0) QK_SOFTMAX(1, 0, 4, d, tp, pf1) QK_SOFTMAX(2, 0, 8, d, tp, pf2) QK_SOFTMAX(3, 0, 12, d, tp, pf3)
        asm volatile("s_waitcnt lgkmcnt(0)" ::: "memory");
        V_TO_LDS(0)
        asm volatile("" ::: "memory");
        if (st + 1 < 18) { const int sn = st + 1, dn = sn < 12 ? 1 : 4, tn = sn < 12 ? 2 * sn : 2 * (sn - 12); LOAD_SET(0, q0a, dn, tn) }
        else { LOAD_SET(0, q0a, 16, 0) }
        asm volatile("s_waitcnt lgkmcnt(0)" ::: "memory");
        u32x2 tv[2][2];
        TR_READ2(0, 0, tv) PV2(0, 0, tv, pf0) PV2(1, 0, tv, pf1) PV2(2, 0, tv, pf2) PV2(3, 0, tv, pf3)
        TR_READ2(0, 2, tv) PV2(0, 2, tv, pf0) PV2(1, 2, tv, pf1) PV2(2, 2, tv, pf2) PV2(3, 2, tv, pf3)
    }
    LOAD_SET(1, q0a + 4, 16, 0)
    for (int s5 = 0; s5 < 5; ++s5) {
        const int tp = 2 * s5;
        {   bf16x8 pfa, pfb;
            QK_SOFTMAX(0, 0, 0, 16, tp, pfa) QK_SOFTMAX(1, 1, 0, 16, tp, pfb)
            asm volatile("s_waitcnt lgkmcnt(0)" ::: "memory");
            V_TO_LDS(0) V_TO_LDS(1)
            asm volatile("" ::: "memory");
            LOAD_SET(0, q0a + 8, 16, tp) LOAD_SET(1, q0a + 12, 16, tp)
            asm volatile("s_waitcnt lgkmcnt(0)" ::: "memory");
            u32x2 tv[2][2];
            TR_READ2(0, 0, tv) PV2(0, 0, tv, pfa) TR_READ2(0, 2, tv) PV2(0, 2, tv, pfa)
            TR_READ2(1, 0, tv) PV2(1, 0, tv, pfb) TR_READ2(1, 2, tv) PV2(1, 2, tv, pfb) }
        {   bf16x8 pfa, pfb;
            QK_SOFTMAX(2, 0, 0, 16, tp, pfa) QK_SOFTMAX(3, 1, 0, 16, tp, pfb)
            asm volatile("s_waitcnt lgkmcnt(0)" ::: "memory");
            V_TO_LDS(0) V_TO_LDS(1)
            asm volatile("" ::: "memory");
            { const int tn = s5 < 4 ? tp + 2 : tp; LOAD_SET(0, q0a, 16, tn) LOAD_SET(1, q0a + 4, 16, tn) }
            asm volatile("s_waitcnt lgkmcnt(0)" ::: "memory");
            u32x2 tv[2][2];
            TR_READ2(0, 0, tv) PV2(2, 0, tv, pfa) TR_READ2(0, 2, tv) PV2(2, 2, tv, pfa)
            TR_READ2(1, 0, tv) PV2(3, 0, tv, pfb) TR_READ2(1, 2, tv) PV2(3, 2, tv, pfb) }
    }
#undef LOAD_SET
#undef V_TO_LDS
#undef QK_SOFTMAX
#undef TR_READ2
#undef PV2
    const float* beta = a.in[I_BETA] + h * 64;
#pragma unroll
    for (int jj = 0; jj < 4; ++jj) {
        float ls = l[jj]; ls += __shfl_xor(ls, 16); ls += __shfl_xor(ls, 32);
        const float inv = 1.f / ls;
        bf16_t* op = MIX + (size_t)(row0 + qp[jj]) * DM + h * 64;
#pragma unroll
        for (int db = 0; db < 4; ++db) { const int dd = 16 * db + 4 * g;
            u32x2 w; w.x = cvt_pk_bf16(O[jj][db][0] * inv * beta[dd], O[jj][db][1] * inv * beta[dd + 1]); w.y = cvt_pk_bf16(O[jj][db][2] * inv * beta[dd + 2], O[jj][db][3] * inv * beta[dd + 3]);
            *(u32x2*)(op + dd) = w; }
    }
}
__device__ void phase_attn(const Args& a, LAS unsigned char* lds) {
    const int wave = threadIdx.x >> 6, lane = threadIdx.x & 63;
    LAS bf16_t* vl = (LAS bf16_t*)(lds + wave * 16384);
    const float gq = wave_max(fabsf(a.in[I_QG][lane])), gk = wave_max(fabsf(a.in[I_KG][lane]));
    const float cshift = 8.f * gq * gk;
    const int njobs = (NTOK / 256) * 8 * 4;
    for (int j = blockIdx.x * 8 + wave; j < njobs; j += gridDim.x * 8) {
        const int r = j & 3, h = (j >> 2) & 7, tb = j >> 5;
        const int rowb = tb * 256;
        int row0, S; if (rowb < NP) { row0 = 0; S = NP; } else { row0 = NP + ((rowb - NP) / SS) * SS; S = SS; }
        attn_job4(a, vl, row0, S, h, rowb - row0 + r, cshift);
    }
}

__device__ __forceinline__ float dpp_x1(float x) { return __int_as_float(__builtin_amdgcn_update_dpp(0, __float_as_int(x), 0xB1, 0xF, 0xF, true)); }
__device__ __forceinline__ float dpp_x2(float x) { return __int_as_float(__builtin_amdgcn_update_dpp(0, __float_as_int(x), 0x4E, 0xF, 0xF, true)); }
__device__ __forceinline__ float quad_sum(float x) { x += dpp_x1(x); x += dpp_x2(x); return x; }
constexpr int SEG = 256, NSEGP = NP / SEG;

template <int MODE>
__device__ void scan_job(const Args& a, LAS float* wl, int row0, int S, int h, int dir, int i0, int n, const float* startp, float* endp, bool emit) {
    const bf16_t* PR = (const bf16_t*)(a.ws + OFF_PR); const bf16_t* LORA = (const bf16_t*)(a.ws + OFF_LORA);
    bf16_t* Y = (bf16_t*)(a.ws + OFF_Y); float* CB = (float*)(a.ws + OFF_C);
    const int lane = threadIdx.x & 63, ch = h * 64 + lane, qd = lane >> 2, kq = lane & 3;
    const float mpr_r = a.in[I_MUP][ch], mnx_r = a.in[I_MUN][ch], mpr_k = a.in[I_MUP][512 + ch], mnx_k = a.in[I_MUN][512 + ch], mpr_v = a.in[I_MUP][1024 + ch], mnx_v = a.in[I_MUN][1024 + ch];
    const float kkc = a.in[I_KK][ch], kac = a.in[I_KA][ch], rkc = a.in[I_RK][ch];
    const float w0c = a.in[I_W0][dir * 512 + ch], a0c = a.in[I_A0][dir * 512 + ch];
    f32x2 St[4][8];
#pragma unroll
    for (int i = 0; i < 4; ++i)
#pragma unroll
        for (int k2 = 0; k2 < 8; ++k2) {
            if (MODE == 1) { const int r = 4 * qd + i, c = kq * 16 + 2 * k2; St[i][k2] = (f32x2){r == c ? 1.f : 0.f, r == c + 1 ? 1.f : 0.f}; }
            else if (startp) St[i][k2] = *(const f32x2*)(startp + (4 * qd + i) * 64 + kq * 16 + 2 * k2);
            else St[i][k2] = (f32x2){0.f, 0.f};
        }
    const int sd = dir ? -1 : 1;
    const int t0 = dir ? S - 1 - i0 : i0;
    float rb = 0.f, kb = 0.f, vb = 0.f, rc, kc, vc, ra = 0.f, ka = 0.f, va = 0.f;
    { const bf16_t* p = PR + (size_t)(row0 + t0) * 1920 + ch; rc = bf2f(p[0]); kc = bf2f(p[512]); vc = bf2f(p[1024]);
      const int tb = t0 - sd, ta = t0 + sd;
      if (tb >= 0 && tb < S) { const bf16_t* q = PR + (size_t)(row0 + tb) * 1920 + ch; rb = bf2f(q[0]); kb = bf2f(q[512]); vb = bf2f(q[1024]); }
      if (ta >= 0 && ta < S) { const bf16_t* q = PR + (size_t)(row0 + ta) * 1920 + ch; ra = bf2f(q[0]); ka = bf2f(q[512]); va = bf2f(q[1024]); } }
    bf16_t nr[4], nk[4], nv[4], lw[4], la[4];
#define SCAN_LOADS(IB, R_, K_, V_, W_, A_) _Pragma("unroll") for (int u = 0; u < 4; ++u) { const int t = t0 + sd * ((IB) + u), t2 = t + 2 * sd; const bool ok = (t2 >= 0 && t2 < S); \
            const bf16_t* p = PR + (size_t)(row0 + (ok ? t2 : t)) * 1920 + ch; \
            R_[u] = ok ? p[0] : (bf16_t)0; K_[u] = ok ? p[512] : (bf16_t)0; V_[u] = ok ? p[1024] : (bf16_t)0; \
            const bf16_t* lp = LORA + (size_t)(row0 + t) * 2048 + dir * 512 + ch; W_[u] = lp[0]; A_[u] = lp[1024]; }
    SCAN_LOADS(0, nr, nk, nv, lw, la)
    for (int ib = 0; ib < n; ib += 4) {
        bf16_t pr_[4], pk_[4], pv_[4], pw_[4], pa_[4];
        { const int ibn = (ib + 4 < n) ? ib + 4 : ib; SCAN_LOADS(ibn, pr_, pk_, pv_, pw_, pa_) }
#pragma unroll
        for (int u = 0; u < 4; ++u) {
            const int t = t0 + sd * (ib + u);
            const float rp = dir ? ra : rb, rn = dir ? rb : ra, kp = dir ? ka : kb, kn = dir ? kb : ka, vp = dir ? va : vb, vn = dir ? vb : va;
            const float r = rc + mpr_r * (rp - rc) + mnx_r * (rn - rc);
            const float k = kc + mpr_k * (kp - kc) + mnx_k * (kn - kc);
            const float v = vc + mpr_v * (vp - vc) + mnx_v * (vn - vc);
            const float wraw = bf2f(lw[u]) + w0c, apre = bf2f(la[u]) + a0c;
            const float w = __expf(-0.60653066f * __builtin_amdgcn_rcpf(1.f + __expf(-wraw)));
            const float av = __builtin_amdgcn_rcpf(1.f + __expf(-apre));
            const float kkr = k * kkc; const float ssq = wave_sum(kkr * kkr);
            const float kk = kkr * rsqrtf(fmaxf(ssq, 1e-24f));
            const float kd = k * (1.f + (av - 1.f) * kac);
            const float bb = kk * av;
            LAS float* o = wl + u * 384;
            o[lane] = w; o[64 + lane] = kk; o[128 + lane] = bb; o[192 + lane] = kd; o[256 + lane] = r; o[320 + lane] = v;
            if (emit) { const float cd = wave_sum(r * kd * rkc); if (lane == 0) CB[((size_t)dir * NTOK + row0 + t) * 8 + h] = cd; }
            rb = rc; kb = kc; vb = vc; rc = ra; kc = ka; vc = va; ra = bf2f(nr[u]); ka = bf2f(nk[u]); va = bf2f(nv[u]);
        }
        asm volatile("s_waitcnt lgkmcnt(0)" ::: "memory");
#pragma unroll
        for (int u = 0; u < 4; ++u) {
            const LAS f32x4* V4 = (const LAS f32x4*)(wl + u * 384);
            f32x4 k4[4];
#pragma unroll
            for (int j = 0; j < 4; ++j) k4[j] = V4[16 + kq * 4 + j];
            float sa[4];
#pragma unroll
            for (int i = 0; i < 4; ++i) { f32x2 a2 = (f32x2){0.f, 0.f};
#pragma unroll
                for (int j = 0; j < 4; ++j) { a2 += St[i][2 * j] * (f32x2){k4[j][0], k4[j][1]}; a2 += St[i][2 * j + 1] * (f32x2){k4[j][2], k4[j][3]}; }
                sa[i] = quad_sum(a2[0] + a2[1]); }
            f32x4 w4[4], b4[4], d4[4], r4[4];
#pragma unroll
            for (int j = 0; j < 4; ++j) { w4[j] = V4[kq * 4 + j]; b4[j] = V4[32 + kq * 4 + j]; if (MODE == 0) { d4[j] = V4[48 + kq * 4 + j]; r4[j] = V4[64 + kq * 4 + j]; } }
            f32x4 vr = (f32x4){0.f, 0.f, 0.f, 0.f};
            if (MODE == 0) vr = V4[80 + qd];
            float yv[4];
#pragma unroll
            for (int i = 0; i < 4; ++i) {
                const f32x2 nsa = (f32x2){-sa[i], -sa[i]}, vv2 = (f32x2){vr[i], vr[i]};
                f32x2 y2 = (f32x2){0.f, 0.f};
#pragma unroll
                for (int j = 0; j < 4; ++j) {
                    f32x2 ta = nsa * (f32x2){b4[j][0], b4[j][1]}, tb = nsa * (f32x2){b4[j][2], b4[j][3]};
                    if (MODE == 0) { ta += vv2 * (f32x2){d4[j][0], d4[j][1]}; tb += vv2 * (f32x2){d4[j][2], d4[j][3]}; }
                    St[i][2 * j] = St[i][2 * j] * (f32x2){w4[j][0], w4[j][1]} + ta; St[i][2 * j + 1] = St[i][2 * j + 1] * (f32x2){w4[j][2], w4[j][3]} + tb;
                    if (MODE == 0) { y2 += St[i][2 * j] * (f32x2){r4[j][0], r4[j][1]}; y2 += St[i][2 * j + 1] * (f32x2){r4[j][2], r4[j][3]}; }
                }
                yv[i] = y2[0] + y2[1];
            }
            if (MODE == 0 && emit) {
#pragma unroll
                for (int i = 0; i < 4; ++i) yv[i] = quad_sum(yv[i]);
                const int t = t0 + sd * (ib + u);
                if (kq == 0) { u32x2 w; w.x = cvt_pk_bf16(yv[0], yv[1]); w.y = cvt_pk_bf16(yv[2], yv[3]);
                    *(u32x2*)(Y + ((size_t)dir * NTOK + row0 + t) * 512 + h * 64 + 4 * qd) = w; }
            }
        }
        asm volatile("s_waitcnt lgkmcnt(0)" ::: "memory");
#pragma unroll
        for (int u = 0; u < 4; ++u) { nr[u] = pr_[u]; nk[u] = pk_[u]; nv[u] = pv_[u]; lw[u] = pw_[u]; la[u] = pa_[u]; }
    }
#undef SCAN_LOADS
    if (endp) {
#pragma unroll
        for (int i = 0; i < 4; ++i)
#pragma unroll
            for (int k2 = 0; k2 < 8; ++k2) *(f32x2*)(endp + (4 * qd + i) * 64 + kq * 16 + 2 * k2) = St[i][k2];
    }
}
__device__ __forceinline__ float* sum_slot(const Args& a, int chain, int seg, int which) { return (float*)(a.ws + OFF_SUM) + ((size_t)(chain * NSEGP + seg) * 2 + which) * 4096; }

__device__ void phase_scan_pass1(const Args& a, LAS unsigned char* lds) {
    const int wave = threadIdx.x >> 6;
    LAS float* wl = (LAS float*)(lds + wave * 16384);
    const int njobs = 16 * (NSEGP - 1) * 2;
    for (int j = blockIdx.x * 8 + wave; j < njobs; j += gridDim.x * 8) {
        const int chain = j / ((NSEGP - 1) * 2), rem = j % ((NSEGP - 1) * 2), seg = rem >> 1, mode = rem & 1;
        if (mode) scan_job<1>(a, wl, 0, NP, chain >> 1, chain & 1, seg * SEG, SEG, nullptr, sum_slot(a, chain, seg, 0), false);
        else scan_job<0>(a, wl, 0, NP, chain >> 1, chain & 1, seg * SEG, SEG, nullptr, sum_slot(a, chain, seg, 1), false);
    }
}
__device__ void combine_chain(const Args& a, LAS unsigned char* lds, int chain, int q) {
    LAS float* Ss = (LAS float*)lds;
    LAS float* Ps = (LAS float*)(lds + 8192);
    const int tid = threadIdx.x, vl = tid >> 5, v = 16 * q + vl, kb = (tid & 31) * 2;
    { const float* q0 = sum_slot(a, chain, 0, 1);
      for (int i = tid; i < 1024; i += 512) Ss[(i >> 6) * 65 + (i & 63)] = q0[(16 * q + (i >> 6)) * 64 + (i & 63)]; }
    f32x4 np0, np1; f32x2 nc;
    { const float* pj = sum_slot(a, chain, 1, 0); const float* qj = sum_slot(a, chain, 1, 1);
      np0 = *(const f32x4*)(pj + tid * 4); np1 = *(const f32x4*)(pj + 2048 + tid * 4); nc = *(const f32x2*)(qj + v * 64 + kb); }
    for (int j = 1; j < NSEGP - 1; ++j) {
        float* qj = sum_slot(a, chain, j, 1);
        *(LAS f32x4*)(Ps + tid * 4) = np0; *(LAS f32x4*)(Ps + 2048 + tid * 4) = np1;
        f32x2 c = nc;
        if (j + 1 < NSEGP - 1) { const float* pn = sum_slot(a, chain, j + 1, 0); const float* qn = sum_slot(a, chain, j + 1, 1);
            np0 = *(const f32x4*)(pn + tid * 4); np1 = *(const f32x4*)(pn + 2048 + tid * 4); nc = *(const f32x2*)(qn + v * 64 + kb); }
        __syncthreads();
#pragma unroll 16
        for (int m = 0; m < 64; ++m) { const float sv = Ss[vl * 65 + m]; const f32x2 p = *(const LAS f32x2*)(Ps + m * 64 + kb); c += sv * p; }
        __syncthreads();
        *(f32x2*)(qj + v * 64 + kb) = c;
        Ss[vl * 65 + kb] = c[0]; Ss[vl * 65 + kb + 1] = c[1];
    }
    __threadfence();
    __syncthreads();
    if (tid == 0) __hip_atomic_fetch_add((int*)(a.ws + OFF_FLAG) + chain, 1, __ATOMIC_RELEASE, __HIP_MEMORY_SCOPE_AGENT);
    __syncthreads();
}
__device__ void rwkv_out_slice(const Args& a, int row0, int h);
struct CoopJob { int row0, S, h, dir, i0; const float* startp; };
__device__ void scan_coop(const Args& a, LAS unsigned char* lds, const CoopJob jA, const CoopJob jB, int n) {
    const bf16_t* PR = (const bf16_t*)(a.ws + OFF_PR); const bf16_t* LORA = (const bf16_t*)(a.ws + OFF_LORA);
    bf16_t* Y = (bf16_t*)(a.ws + OFF_Y); float* CB = (float*)(a.ws + OFF_C);
    const int wave = __builtin_amdgcn_readfirstlane(threadIdx.x >> 6), lane = threadIdx.x & 63, c = wave >> 2, rg = wave & 3, qd = lane >> 2, kq = lane & 3;
    const int row0 = c ? jB.row0 : jA.row0, S = c ? jB.S : jA.S, h = c ? jB.h : jA.h, dir = c ? jB.dir : jA.dir, i0 = c ? jB.i0 : jA.i0;
    const float* startp = c ? jB.startp : jA.startp;
    LAS float* buf = (LAS float*)lds + c * (2 * 8 * 384);
    const int ch = h * 64 + lane;
    const float mpr_r = a.in[I_MUP][ch], mnx_r = a.in[I_MUN][ch], mpr_k = a.in[I_MUP][512 + ch], mnx_k = a.in[I_MUN][512 + ch], mpr_v = a.in[I_MUP][1024 + ch], mnx_v = a.in[I_MUN][1024 + ch];
    const float kkc = a.in[I_KK][ch], kac = a.in[I_KA][ch], rkc = a.in[I_RK][ch];
    const float w0c = a.in[I_W0][dir * 512 + ch], a0c = a.in[I_A0][dir * 512 + ch];
    const int myrow = 16 * rg + qd;
    f32x2 St[8];
#pragma unroll
    for (int k2 = 0; k2 < 8; ++k2) St[k2] = startp ? *(const f32x2*)(startp + myrow * 64 + kq * 16 + 2 * k2) : (f32x2){0.f, 0.f};
    const int sd = dir ? -1 : 1, t0 = dir ? S - 1 - i0 : i0;
    bf16_t lr[2][3], lk[2][3], lv[2][3], lw[2], la[2];
    const bf16_t* prp = PR + (size_t)(row0 + t0 + sd * rg) * 1920 + ch;
    const bf16_t* lop = LORA + (size_t)(row0 + t0 + sd * rg) * 2048 + dir * 512 + ch;
    float* cbp = CB + ((size_t)dir * NTOK + row0 + t0 + sd * rg) * 8 + h;
    bf16_t* ypw = Y + ((size_t)dir * NTOK + row0 + t0) * 512 + h * 64 + myrow;
    const long rstep = (long)sd * 1920, lstep = (long)sd * 2048;
#define COOP_LOADS(IB, R_, K_, V_, W_, A_) _Pragma("unroll") for (int e = 0; e < 2; ++e) { const int t = t0 + sd * ((IB) + 4 * e + rg); const bool okp = t > 0, okn = t < S - 1; \
        const bf16_t* p = prp + rstep * ((IB) + 4 * e); \
        R_[e][1] = p[0]; K_[e][1] = p[512]; V_[e][1] = p[1024]; \
        const bf16_t r0_ = p[-1920], k0_ = p[-1920 + 512], v0_ = p[-1920 + 1024], r2_ = p[1920], k2_ = p[1920 + 512], v2_ = p[1920 + 1024]; \
        R_[e][0] = okp ? r0_ : (bf16_t)0; K_[e][0] = okp ? k0_ : (bf16_t)0; V_[e][0] = okp ? v0_ : (bf16_t)0; \
        R_[e][2] = okn ? r2_ : (bf16_t)0; K_[e][2] = okn ? k2_ : (bf16_t)0; V_[e][2] = okn ? v2_ : (bf16_t)0; \
        const bf16_t* lp = lop + lstep * ((IB) + 4 * e); W_[e] = lp[0]; A_[e] = lp[1024]; }
    COOP_LOADS(0, lr, lk, lv, lw, la)
    for (int ib = 0; ib < n; ib += 8) {
        bf16_t nr[2][3], nk[2][3], nv[2][3], nw[2], na[2];
        { const int ibn = (ib + 8 < n) ? ib + 8 : ib; COOP_LOADS(ibn, nr, nk, nv, nw, na) }
        LAS float* bb = buf + ((ib >> 3) & 1) * (8 * 384);
#pragma unroll
        for (int e = 0; e < 2; ++e) {
            const int t = t0 + sd * (ib + 4 * e + rg);
            const float rc = bf2f(lr[e][1]), kc = bf2f(lk[e][1]), vc = bf2f(lv[e][1]);
            const float r = rc + mpr_r * (bf2f(lr[e][0]) - rc) + mnx_r * (bf2f(lr[e][2]) - rc);
            const float k = kc + mpr_k * (bf2f(lk[e][0]) - kc) + mnx_k * (bf2f(lk[e][2]) - kc);
            const float v = vc + mpr_v * (bf2f(lv[e][0]) - vc) + mnx_v * (bf2f(lv[e][2]) - vc);
            const float wraw = bf2f(lw[e]) + w0c, apre = bf2f(la[e]) + a0c;
            const float w = __expf(-0.60653066f * __builtin_amdgcn_rcpf(1.f + __expf(-wraw)));
            const float av = __builtin_amdgcn_rcpf(1.f + __expf(-apre));
            const float kkr = k * kkc; const float ssq = wave_sum(kkr * kkr);
            const float kk = kkr * rsqrtf(fmaxf(ssq, 1e-24f));
            const float kd = k * (1.f + (av - 1.f) * kac);
            const float bq = kk * av;
            const float cd = wave_sum(r * kd * rkc);
            LAS float* o = bb + (4 * e + rg) * 384;
            o[lane] = w; o[64 + lane] = kk; o[128 + lane] = bq; o[192 + lane] = kd; o[256 + lane] = r; o[320 + lane] = v;
            cbp[(long)sd * 8 * (ib + 4 * e)] = cd;
        }
        asm volatile("s_waitcnt lgkmcnt(0)" ::: "memory");
        __builtin_amdgcn_s_barrier();
        asm volatile("" ::: "memory");
        f32x4 vb_[2][20]; float vr_[2];
#define ROW_LOAD(U) { const LAS f32x4* V4 = (const LAS f32x4*)(bb + (U) * 384); \
            _Pragma("unroll") for (int j = 0; j < 4; ++j) { vb_[(U) & 1][j] = V4[16 + kq * 4 + j]; vb_[(U) & 1][4 + j] = V4[kq * 4 + j]; vb_[(U) & 1][8 + j] = V4[32 + kq * 4 + j]; \
                vb_[(U) & 1][12 + j] = V4[48 + kq * 4 + j]; vb_[(U) & 1][16 + j] = V4[64 + kq * 4 + j]; } \
            vr_[(U) & 1] = bb[(U) * 384 + 320 + myrow]; }
        ROW_LOAD(0)
#pragma unroll
        for (int u = 0; u < 8; ++u) {
            if (u < 7) ROW_LOAD(u + 1)
            __builtin_amdgcn_sched_barrier(0);
            const f32x4* cv = vb_[u & 1];
            const float vr = vr_[u & 1];
            const f32x2 vv2 = (f32x2){vr, vr};
            f32x2 a0 = St[0] * (f32x2){cv[0][0], cv[0][1]}, a1 = St[1] * (f32x2){cv[0][2], cv[0][3]};
            f32x2 a2 = St[2] * (f32x2){cv[1][0], cv[1][1]}, a3 = St[3] * (f32x2){cv[1][2], cv[1][3]};
            a0 += St[4] * (f32x2){cv[2][0], cv[2][1]}; a1 += St[5] * (f32x2){cv[2][2], cv[2][3]};
            a2 += St[6] * (f32x2){cv[3][0], cv[3][1]}; a3 += St[7] * (f32x2){cv[3][2], cv[3][3]};
            f32x2 P[8];
#pragma unroll
            for (int j = 0; j < 4; ++j) { const f32x4 w4 = cv[4 + j], d4 = cv[12 + j];
                P[2 * j] = St[2 * j] * (f32x2){w4[0], w4[1]} + vv2 * (f32x2){d4[0], d4[1]};
                P[2 * j + 1] = St[2 * j + 1] * (f32x2){w4[2], w4[3]} + vv2 * (f32x2){d4[2], d4[3]}; }
            const f32x2 as_ = (a0 + a1) + (a2 + a3);
            const float sa = quad_sum(as_[0] + as_[1]);
            const f32x2 nsa = (f32x2){-sa, -sa};
#pragma unroll
            for (int j = 0; j < 4; ++j) { const f32x4 b4 = cv[8 + j];
                St[2 * j] = nsa * (f32x2){b4[0], b4[1]} + P[2 * j]; St[2 * j + 1] = nsa * (f32x2){b4[2], b4[3]} + P[2 * j + 1]; }
            f32x2 y0 = St[0] * (f32x2){cv[16][0], cv[16][1]}, y1 = St[1] * (f32x2){cv[16][2], cv[16][3]};
            f32x2 y2 = St[2] * (f32x2){cv[17][0], cv[17][1]}, y3 = St[3] * (f32x2){cv[17][2], cv[17][3]};
            y0 += St[4] * (f32x2){cv[18][0], cv[18][1]}; y1 += St[5] * (f32x2){cv[18][2], cv[18][3]};
            y2 += St[6] * (f32x2){cv[19][0], cv[19][1]}; y3 += St[7] * (f32x2){cv[19][2], cv[19][3]};
            const f32x2 ys_ = (y0 + y1) + (y2 + y3);
            const float y = quad_sum(ys_[0] + ys_[1]);
            ypw[(long)sd * 512 * (ib + u)] = (bf16_t)cvt_pk_bf16(y, y);
        }
#undef ROW_LOAD
#pragma unroll
        for (int e = 0; e < 2; ++e) {
#pragma unroll
            for (int q = 0; q < 3; ++q) { lr[e][q] = nr[e][q]; lk[e][q] = nk[e][q]; lv[e][q] = nv[e][q]; }
            lw[e] = nw[e]; la[e] = na[e]; }
    }
#undef COOP_LOADS
    __syncthreads();
}
__device__ void phase_scan_main(const Args& a, LAS unsigned char* lds, bool comb) {
    if (comb) for (int cj = blockIdx.x; cj < 64; cj += gridDim.x) combine_chain(a, lds, cj >> 2, cj & 3);
    for (int j = blockIdx.x; j < 256; j += gridDim.x) { const int sq = j >> 3, h = j & 7;
        CoopJob A; A.row0 = NP + sq * SS; A.S = SS; A.h = h; A.dir = 0; A.i0 = 0; A.startp = nullptr; CoopJob B = A; B.dir = 1;
        scan_coop(a, lds, A, B, SS);
        __threadfence(); __syncthreads();
        rwkv_out_slice(a, A.row0, h); }
    for (int pj = blockIdx.x; pj < 8 * NSEGP; pj += gridDim.x) { const int id = 2 * pj, chain = id / NSEGP, seg = id % NSEGP;
        const int* fl = (const int*)(a.ws + OFF_FLAG) + chain;
        while (__hip_atomic_load(fl, __ATOMIC_ACQUIRE, __HIP_MEMORY_SCOPE_AGENT) < 4) __builtin_amdgcn_s_sleep(8);
        CoopJob A; A.row0 = 0; A.S = NP; A.h = chain >> 1; A.dir = chain & 1; A.i0 = seg * SEG; A.startp = seg ? sum_slot(a, chain, seg - 1, 1) : nullptr;
        CoopJob B = A; B.i0 = (seg + 1) * SEG; B.startp = sum_slot(a, chain, seg, 1);
        scan_coop(a, lds, A, B, SEG); }
}

struct RwkvOutConst { float mp[8], mn[8], lw[8], lb[8]; };
__device__ __forceinline__ void rwkv_out_load_const(const Args& a, int ch, RwkvOutConst& c) {
#pragma unroll
    for (int j = 0; j < 8; ++j) { c.mp[j] = a.in[I_MUP][1024 + ch + j]; c.mn[j] = a.in[I_MUN][1024 + ch + j]; c.lw[j] = a.in[I_LNW][ch + j]; c.lb[j] = a.in[I_LNB][ch + j]; }
}
__device__ __forceinline__ void rwkv_out_item(const Args& a, int row, int ch, int h, const RwkvOutConst& c) {
    const bf16_t* PR = (const bf16_t*)(a.ws + OFF_PR); const bf16_t* Y = (const bf16_t*)(a.ws + OFF_Y); const float* CB = (const float*)(a.ws + OFF_C);
    const bf16_t* G = (const bf16_t*)((const unsigned char*)a.out + OUT_OFF_G); bf16_t* MIX = (bf16_t*)(a.ws + OFF_H);
    int pos, S; if (row < NP) { pos = row; S = NP; } else { pos = (row - NP) % SS; S = SS; }
    const bool hp = pos > 0, hn = pos < S - 1;
    const u32x4 yf = *(const u32x4*)(Y + (size_t)row * 512 + ch), yb = *(const u32x4*)(Y + ((size_t)NTOK + row) * 512 + ch);
    const u32x4 gg = *(const u32x4*)(G + (size_t)row * 512 + ch);
    const bf16_t* vp = PR + (size_t)row * 1920 + 1024 + ch;
    const u32x4 vc = *(const u32x4*)vp;
    const u32x4 vpv = hp ? *(const u32x4*)(vp - 1920) : (u32x4){0u, 0u, 0u, 0u};
    const u32x4 vnx = hn ? *(const u32x4*)(vp + 1920) : (u32x4){0u, 0u, 0u, 0u};
    const float cs = CB[(size_t)row * 8 + h] + CB[((size_t)NTOK + row) * 8 + h];
    float y[8], gv[8], vs[8];
#pragma unroll
    for (int j = 0; j < 4; ++j) {
        y[2 * j] = lo_bf(yf[j]) + lo_bf(yb[j]); y[2 * j + 1] = hi_bf(yf[j]) + hi_bf(yb[j]);
        gv[2 * j] = lo_bf(gg[j]); gv[2 * j + 1] = hi_bf(gg[j]);
        const float c0 = lo_bf(vc[j]), c1 = hi_bf(vc[j]);
        vs[2 * j] = c0 + c.mp[2 * j] * (lo_bf(vpv[j]) - c0) + c.mn[2 * j] * (lo_bf(vnx[j]) - c0);
        vs[2 * j + 1] = c1 + c.mp[2 * j + 1] * (hi_bf(vpv[j]) - c1) + c.mn[2 * j + 1] * (hi_bf(vnx[j]) - c1);
    }
    float s = 0.f;
#pragma unroll
    for (int j = 0; j < 8; ++j) s += y[j];
    s += __shfl_xor(s, 1); s += __shfl_xor(s, 2); s += __shfl_xor(s, 4);
    const float mu = s * (1.f / 64.f);
    float q = 0.f;
#pragma unroll
    for (int j = 0; j < 8; ++j) { const float dlt = y[j] - mu; q += dlt * dlt; }
    q += __shfl_xor(q, 1); q += __shfl_xor(q, 2); q += __shfl_xor(q, 4);
    const float rs = rsqrtf(q * (1.f / 64.f) + LNX_EPS);
    float o[8];
#pragma unroll
    for (int j = 0; j < 8; ++j) o[j] = ((y[j] - mu) * rs * c.lw[j] + c.lb[j] + cs * vs[j]) * gv[j];
    u32x4 w; w.x = cvt_pk_bf16(o[0], o[1]); w.y = cvt_pk_bf16(o[2], o[3]); w.z = cvt_pk_bf16(o[4], o[5]); w.w = cvt_pk_bf16(o[6], o[7]);
    *(u32x4*)(MIX + (size_t)row * DM + 512 + ch) = w;
}
__device__ void phase_rwkv_out(const Args& a) {
    const int wave = threadIdx.x >> 6, lane = threadIdx.x & 63, ch = lane * 8, h = lane >> 3;
    RwkvOutConst c; rwkv_out_load_const(a, ch, c);
    for (int row = blockIdx.x * 8 + wave; row < NP; row += gridDim.x * 8) rwkv_out_item(a, row, ch, h, c);
}
__device__ void rwkv_out_slice(const Args& a, int row0, int h) {
    const int wave = threadIdx.x >> 6, lane = threadIdx.x & 63, ch = h * 64 + (lane & 7) * 8;
    RwkvOutConst c; rwkv_out_load_const(a, ch, c);
    for (int r = wave * 8 + (lane >> 3); r < SS; r += 64) rwkv_out_item(a, row0 + r, ch, h, c);
}

#define XB_TMO      128
#define XB_XCNT(j)  (256  + 64 * (j))
#define XB_XSUB(j)  (1280 + 64 * (j))
#define XB_XGEN(j)  (2304 + 64 * (j))
#define XB_TOP      3328
#define XB_TOPGEN   3392
#define XCD_BAR_WORDS 3456
#define XB_SPIN_CAP (1u << 18)
__device__ __forceinline__ unsigned xb_ld(unsigned* p)              { return __hip_atomic_load(p, __ATOMIC_RELAXED, __HIP_MEMORY_SCOPE_AGENT); }
__device__ __forceinline__ unsigned xb_add(unsigned* p, unsigned v) { return __hip_atomic_fetch_add(p, v, __ATOMIC_RELAXED, __HIP_MEMORY_SCOPE_AGENT); }
__device__ __forceinline__ unsigned xb_xcc_id() { return (unsigned)__builtin_amdgcn_s_getreg((3 << 11) | 20) & 0xFu; }
#define XB_SPIN(cond, bar) do { unsigned _sp = 0; while (cond) { __builtin_amdgcn_s_sleep(1); \
    if ((++_sp & 255u) == 0u) { if (xb_ld(&(bar)[XB_TMO])) break; if (_sp > XB_SPIN_CAP) { atomicAdd(&(bar)[XB_TMO], 1u); break; } } } } while (0)
struct XcdBarrier { unsigned* bar; unsigned x; volatile LAS unsigned* st; };
__device__ __forceinline__ XcdBarrier xcd_barrier_post(unsigned* bar, volatile LAS unsigned* st) {
    XcdBarrier b; b.bar = bar; b.x = xb_xcc_id(); b.st = st;
    if (threadIdx.x == 0) (void)xb_add(&bar[XB_XCNT(b.x)], 1u);
    return b;
}
__device__ __forceinline__ void xcd_barrier_complete(unsigned* bar, unsigned x, unsigned& nloc, unsigned& nx) {
    const unsigned G = gridDim.x * gridDim.y * gridDim.z;
    unsigned sum, cnt, mine, sp = 0u;
    for (;;) {
        sum = 0u; cnt = 0u; mine = 0u;
#pragma unroll
        for (unsigned j = 0; j < 16; ++j) { const unsigned c = xb_ld(&bar[XB_XCNT(j)]); sum += c; cnt += (c > 0u) ? 1u : 0u; mine = (j == x) ? c : mine; }
        if (sum == G) break;
        __builtin_amdgcn_s_sleep(1);
        if ((++sp & 255u) == 0u) { if (xb_ld(&bar[XB_TMO])) break; if (sp > XB_SPIN_CAP) { atomicAdd(&bar[XB_TMO], 1u); break; } }
    }
    nloc = mine > 0u ? mine : 1u; nx = cnt > 0u ? cnt : 1u;
}
__device__ __forceinline__ void xcd_barrier(const XcdBarrier& b) {
    asm volatile("s_waitcnt vmcnt(0)" ::: "memory");
    __syncthreads();
    if (threadIdx.x == 0) {
        unsigned* bar = b.bar;
        __builtin_amdgcn_s_waitcnt(0);
        unsigned nloc = b.st[0], nx = b.st[1];
        if (nloc == 0u) { xcd_barrier_complete(bar, b.x, nloc, nx); b.st[0] = nloc; b.st[1] = nx; }
        const unsigned old = xb_add(&bar[XB_XSUB(b.x)], 1u);
        const unsigned gen = old / nloc;
        if (old + 1u == (gen + 1u) * nloc) {
            __builtin_amdgcn_fence(__ATOMIC_RELEASE, "agent");
            asm volatile("s_waitcnt vmcnt(0)" ::: "memory");
            const unsigned og = xb_add(&bar[XB_TOP], 1u);
            const unsigned tg = og / nx;
            if (og + 1u == (tg + 1u) * nx) xb_add(&bar[XB_TOPGEN], 1u);
            else XB_SPIN(xb_ld(&bar[XB_TOPGEN]) == tg, bar);
            __builtin_amdgcn_fence(__ATOMIC_ACQUIRE, "agent");
            xb_add(&bar[XB_XGEN(b.x)], 1u);
            asm volatile("s_waitcnt vmcnt(0)" ::: "memory");
        } else {
            XB_SPIN(xb_ld(&bar[XB_XGEN(b.x)]) == gen, bar);
            __builtin_amdgcn_fence(__ATOMIC_ACQUIRE, "agent");
            asm volatile("s_waitcnt vmcnt(0)" ::: "memory");
        }
    }
    __syncthreads();
}

template <class Epi>
__device__ __forceinline__ void run_gemm(LAS unsigned char* lds, const bf16_t* A, const bf16_t* Bt, int N, int K, const Epi& E) {
    pg8::Gemm g; g.A = A; g.Bt = Bt; g.M = NTOK; g.N = N; g.K = K;
    pg8::StaticOrder S; S.init(NTOK, N, (int)gridDim.x, (int)blockIdx.x);
    pg8::gemm_phase<Epi>(lds, g, S, E);
}

__global__ void __launch_bounds__(512, 2) mega(Args a) {
    extern __shared__ __attribute__((aligned(16))) unsigned char shm[];
    LAS unsigned char* lds = (LAS unsigned char*)shm;
    cg::grid_group grid = cg::this_grid();
    volatile LAS unsigned* xst = (volatile LAS unsigned*)(lds + 131072);
    if (threadIdx.x == 0) { xst[0] = 0u; xst[1] = 0u; }
    __syncthreads();
    XcdBarrier xb; xb.bar = (unsigned*)(a.ws + OFF_BAR); xb.x = 0u; xb.st = xst;
#ifndef PHMASK
#define PHMASK 0xFFF
#endif
#ifndef DUP
#define DUP 0
#endif
#define PHASE(k, body) if (a.ph_lo <= (k) && (k) < a.ph_hi) { if ((k) != a.ph_lo) { if ((k) == 1) { grid.sync(); xb = xcd_barrier_post((unsigned*)(a.ws + OFF_BAR), xst); } else xcd_barrier(xb); } if constexpr ((PHMASK >> (k)) & 1) { body } }
    PHASE(0, phase_prep_weights(a, lds); phase_mod(a, lds); if (DUP & 8) { phase_prep_weights(a, lds); phase_mod(a, lds); })
    PHASE(1, phase_norm(a, a.in[I_XP], a.in[I_XS], a.in[I_G1], 0, 1024); if (DUP & 32) phase_norm(a, a.in[I_XP], a.in[I_XS], a.in[I_G1], 0, 1024);)
    PHASE(2, EpiIn E; E.QKV = (bf16_t*)a.out; E.PR = (bf16_t*)(a.ws + OFF_PR); E.qg = a.in[I_QG]; E.kg = a.in[I_KG];
             run_gemm(lds, (const bf16_t*)(a.ws + OFF_H), (const bf16_t*)(a.ws + OFF_WIN), NINP, 1024, E); if (DUP & 16) run_gemm(lds, (const bf16_t*)(a.ws + OFF_H), (const bf16_t*)(a.ws + OFF_WIN), NINP, 1024, E);)
    PHASE(3, phase_post_in(a); if (DUP & 64) { for (int q = 0; q < 10; ++q) grid.sync(); })
    PHASE(4, EpiLora E; E.LORA = (bf16_t*)(a.ws + OFF_LORA); E.G = (bf16_t*)((unsigned char*)a.out + OUT_OFF_G); E.w0 = a.in[I_W0]; E.a0 = a.in[I_A0];
             run_gemm(lds, (const bf16_t*)(a.ws + OFF_X5), (const bf16_t*)(a.ws + OFF_WL), 2560, 384, E);)
    PHASE(5, phase_attn(a, lds); if (DUP & 1) phase_attn(a, lds); phase_scan_pass1(a, lds); if (DUP & 4) phase_scan_pass1(a, lds);)
    PHASE(6, phase_scan_main(a, lds, true); if (DUP & 2) phase_scan_main(a, lds, false);)
    PHASE(7, phase_rwkv_out(a); if (DUP & 32) phase_rwkv_out(a);)
    PHASE(8, EpiRes E; E.out = a.out; E.xp = a.in[I_XP]; E.xs = a.in[I_XS]; E.mod = (const float*)(a.ws + OFF_MOD); E.gate_off = 2048;
             run_gemm(lds, (const bf16_t*)(a.ws + OFF_H), (const bf16_t*)(a.ws + OFF_WOUT), 1024, 1024, E);)
    PHASE(9, phase_norm(a, a.out, a.out + (size_t)NP * DM, a.in[I_G2], 3072, 4096);)
    PHASE(10, EpiFf1 E; E.HID = (bf16_t*)(a.ws + OFF_HID);
             run_gemm(lds, (const bf16_t*)(a.ws + OFF_H), (const bf16_t*)(a.ws + OFF_WFF1), DFF, 1024, E); if (DUP & 16) run_gemm(lds, (const bf16_t*)(a.ws + OFF_H), (const bf16_t*)(a.ws + OFF_WFF1), DFF, 1024, E);)
    PHASE(11, EpiRes E; E.out = a.out; E.xp = nullptr; E.xs = nullptr; E.mod = (const float*)(a.ws + OFF_MOD); E.gate_off = 5120;
             run_gemm(lds, (const bf16_t*)(a.ws + OFF_HID), (const bf16_t*)(a.ws + OFF_WFF2), 1024, DFF, E);)
}

#ifndef N_LAUNCHES
#define N_LAUNCHES 1
#endif

extern "C" void kernel_launch(void* const* d_in, const int* in_sizes, int n_in, void* d_out, int out_size, void* d_ws, size_t ws_size, hipStream_t stream) {
    static int grid = 0;
    if (grid == 0) {
        if (n_in != 27 || out_size != NTOK * DM || ws_size < WS_END) { fprintf(stderr, "kernel_launch: unexpected shapes (n_in %d out %d ws %zu need %zu)\n", n_in, out_size, ws_size, (size_t)WS_END); grid = -1; return; }
        int dev = 0, cus = 0, per_cu = 0;
        hipGetDevice(&dev);
        hipDeviceGetAttribute(&cus, hipDeviceAttributeMultiprocessorCount, dev);
        hipFuncSetAttribute((const void*)mega, hipFuncAttributeMaxDynamicSharedMemorySize, LDS_BYTES);
        hipOccupancyMaxActiveBlocksPerMultiprocessor(&per_cu, (const void*)mega, 512, LDS_BYTES);
        if (per_cu < 1) { fprintf(stderr, "kernel_launch: occupancy query says %d blocks/CU\n", per_cu); per_cu = 1; }
        grid = cus * per_cu;
        (void)hipGetLastError();
    }
    if (grid < 0) return;
    Args a{};
    for (int i = 0; i < 27; ++i) a.in[i] = (const float*)d_in[i];
    a.out = (float*)d_out; a.ws = (unsigned char*)d_ws;
    if (N_LAUNCHES == 1) {
        a.ph_lo = 0; a.ph_hi = NPH;
        void* args[] = {&a};
        hipError_t e = hipLaunchCooperativeKernel((const void*)mega, dim3(grid), dim3(512), args, LDS_BYTES, stream);
        if (e != hipSuccess) fprintf(stderr, "cooperative launch failed: %s (grid %d)\n", hipGetErrorString(e), grid);
    } else {
        for (int ph = 0; ph < NPH; ++ph) {
            a.ph_lo = ph; a.ph_hi = ph + 1;
            void* args[] = {&a};
            hipError_t e = hipLaunchCooperativeKernel((const void*)mega, dim3(grid), dim3(512), args, LDS_BYTES, stream);
            if (e != hipSuccess) fprintf(stderr, "cooperative launch failed: %s (grid %d)\n", hipGetErrorString(e), grid);
        }
    }
}
```

```cpp
#include <hip/hip_runtime.h>
#include <hip/hip_cooperative_groups.h>
#include <cstdio>
namespace cg = cooperative_groups;

#define LAS __attribute__((address_space(3)))
typedef unsigned short bf16_t;
typedef short bf16x8 __attribute__((ext_vector_type(8)));
typedef float f32x4 __attribute__((ext_vector_type(4)));
typedef float f32x2 __attribute__((ext_vector_type(2)));
typedef unsigned u32x4 __attribute__((ext_vector_type(4)));
typedef unsigned u32x2 __attribute__((ext_vector_type(2)));

constexpr int NTOK = 81920, NP = 16384, SS = 2048, DM = 1024, NSEQ = 33;
constexpr int NIN = 3456, NINP = 3584, DFF = 4096;
constexpr float NORM_EPS = 1e-6f, LNX_EPS = 64e-5f;
constexpr int LDS_BYTES = 131072 + 16;
constexpr int NPH = 12;

constexpr size_t OFF_WIN = 0;
constexpr size_t OFF_WOUT = OFF_WIN + (size_t)NINP * 1024 * 2;
constexpr size_t OFF_WFF1 = OFF_WOUT + (size_t)1024 * 1024 * 2;
constexpr size_t OFF_WFF2 = OFF_WFF1 + (size_t)4096 * 1024 * 2;
constexpr size_t OFF_WL = OFF_WFF2 + (size_t)1024 * 4096 * 2;
constexpr size_t OFF_MOD = OFF_WL + (size_t)2560 * 384 * 2;
constexpr size_t OFF_C = OFF_MOD + (size_t)NSEQ * 6144 * 4;
constexpr size_t OFF_H = OFF_C + (size_t)2 * NTOK * 8 * 4;
constexpr size_t OFF_PR = OFF_H + (size_t)NTOK * 1024 * 2;
constexpr size_t OFF_LORA = OFF_PR + (size_t)NTOK * 1920 * 2;
constexpr size_t OFF_Y = OFF_LORA + (size_t)NTOK * 2048 * 2;
constexpr size_t OFF_SUM = OFF_Y + (size_t)NTOK * 1024 * 2;
constexpr size_t OFF_FLAG = OFF_SUM + (size_t)16 * 64 * 32768;
constexpr size_t OFF_BAR = OFF_FLAG + 256;
constexpr size_t BAR_BYTES = 3456 * 4;
constexpr size_t WS_END = OFF_BAR + 16384;
constexpr size_t OFF_X5 = OFF_Y;
constexpr size_t OFF_HID = OFF_PR;
static_assert(OFF_HID + (size_t)NTOK * 4096 * 2 <= WS_END, "hid fits");
constexpr size_t OUT_OFF_G = (size_t)NTOK * 1536 * 2;

struct Args {
    const float* in[27];
    float* out;
    unsigned char* ws;
    int ph_lo, ph_hi;
};
enum { I_XP = 0, I_XS, I_CP, I_CS, I_WADA, I_BADA, I_G1, I_G2, I_WIN, I_QG, I_KG, I_BETA, I_MUP, I_MUN, I_W0, I_WUP, I_A0, I_AUP, I_GUP, I_KK, I_KA, I_RK, I_LNW, I_LNB, I_WOUT, I_WFF1, I_WFF2 };

__device__ __forceinline__ float bf2f(bf16_t b) { return __uint_as_float(((unsigned)b) << 16); }
__device__ __forceinline__ bf16_t f2bf(float f) { unsigned u = __float_as_uint(f); u += 0x7FFFu + ((u >> 16) & 1u); return (bf16_t)(u >> 16); }
__device__ __forceinline__ unsigned cvt_pk_bf16(float lo, float hi) { unsigned r; asm volatile("v_cvt_pk_bf16_f32 %0, %1, %2" : "=v"(r) : "v"(lo), "v"(hi)); return r; }
__device__ __forceinline__ float lo_bf(unsigned u) { return __uint_as_float(u << 16); }
__device__ __forceinline__ float hi_bf(unsigned u) { return __uint_as_float(u & 0xffff0000u); }
template <int CTRL> __device__ __forceinline__ float dpp_mov(float x) { return __int_as_float(__builtin_amdgcn_update_dpp(0, __float_as_int(x), CTRL, 0xF, 0xF, true)); }
__device__ __forceinline__ float wave_sum(float v) {
    v += dpp_mov<0xB1>(v); v += dpp_mov<0x4E>(v); v += dpp_mov<0x141>(v); v += dpp_mov<0x140>(v);
    const float s0 = __int_as_float(__builtin_amdgcn_readlane(__float_as_int(v), 0)), s1 = __int_as_float(__builtin_amdgcn_readlane(__float_as_int(v), 16));
    const float s2 = __int_as_float(__builtin_amdgcn_readlane(__float_as_int(v), 32)), s3 = __int_as_float(__builtin_amdgcn_readlane(__float_as_int(v), 48));
    return (s0 + s1) + (s2 + s3);
}
__device__ __forceinline__ float wave_max(float v) {
#pragma unroll
    for (int o = 32; o >= 1; o >>= 1) v = fmaxf(v, __shfl_xor(v, o));
    return v;
}
__device__ __forceinline__ int seq_of_row(int row) { return row < NP ? 0 : 1 + (row - NP) / SS; }

namespace pg8 {
constexpr int BM = 256, BK = 64, HALF = 128, HTB = HALF * BK * 2, STAGE_BYTES = 8 * HTB, NXCD = 8, WGM = 8;
__device__ __forceinline__ int lds_byte(int r, int c) { const int st = (r >> 4) * 2 + (c >> 5), rr = r & 15, cc = c & 31, ob = rr * 64 + cc * 2; return st * 1024 + (ob ^ (((ob >> 9) & 1) << 5)); }
__device__ __forceinline__ void stage_rc(int b, int& R, int& C) { const int st = b / 1024, sb = b % 1024, swz = sb ^ (((sb >> 9) & 1) << 5); R = (st >> 1) * 16 + swz / 64; C = (st & 1) * 32 + (swz % 64) / 2; }
__device__ __forceinline__ int perm32(int rho) { const int n = rho >> 4, i = rho & 15; return 8 * (i >> 2) + 4 * n + (i & 3); }
struct Unit { int pm, pn; };
struct Gemm { const bf16_t* A; const bf16_t* Bt; int M, N, K; };
struct StaticOrder {
    int nM, nN, nwg, G, c;
    __device__ void init(int M, int N, int G_, int c_) { nM = M / BM; nN = N / BM; nwg = nM * nN; G = G_; c = c_; }
    __device__ bool next(int i, Unit& u) const {
        const long L = (long)i * G + c; if (L >= nwg) return false;
        int wgid = (int)L; { const int q = nwg / NXCD, r = nwg % NXCD, xcd = wgid % NXCD, off = wgid / NXCD; wgid = (xcd < r ? xcd * (q + 1) : r * (q + 1) + (xcd - r) * q) + off; }
        const int nig = WGM * nN, gid = wgid / nig, fm = gid * WGM, gsz = (nM - fm) < WGM ? (nM - fm) : WGM;
        u.pm = fm + ((wgid % nig) % gsz); u.pn = (wgid % nig) / gsz; return true;
    }
};

template <class Epi>
__device__ __forceinline__ void gemm_phase(LAS unsigned char* lds, const Gemm g, const StaticOrder& S, const Epi& E) {
    const int tid = threadIdx.x, wid = __builtin_amdgcn_readfirstlane(tid >> 6), lane = tid & 63, wr = wid >> 2, wc = wid & 3, fr = lane & 15, fq = lane >> 4;
    const int K = g.K, nt = K / BK;
    unsigned voffA[2], voffB[2];
#pragma unroll
    for (int i = 0; i < 2; ++i) { int R, C; stage_rc(tid * 16 + i * 8192, R, C); const int Rb = Epi::PERM ? ((R & ~31) + perm32(R & 31)) : R;
        const int Rh = 64 * (R >> 5) + perm32(R & 31);
        voffA[i] = (unsigned)(R * K + C) * 2u; voffB[i] = (unsigned)((Epi::HEADMAP ? Rh : Rb) * K + C) * 2u; }
    const size_t kstep = (size_t)(BK * 2);
    const size_t hstep = (size_t)HALF * K * 2;
    const size_t tstep = 2 * hstep;
    const size_t hstepB = Epi::HEADMAP ? (size_t)32 * K * 2 : hstep;
    const unsigned ldsw = (unsigned)wid * 1024u;
    const int aoff = lds_byte(wr * 64 + fr, fq * 8), boff = lds_byte(wc * 32 + fr, fq * 8);
#define PG8_SA(b, h) (((b) * 2 + (h)) * HTB)
#define PG8_SB(b, h) ((4 + (b) * 2 + (h)) * HTB)
#define PG8_STAGE(bufoff, gbase, voff) do { _Pragma("unroll") for (int _i = 0; _i < 2; ++_i) \
        __builtin_amdgcn_global_load_lds((const unsigned*)((const char*)(gbase) + (voff)[_i]), (LAS unsigned*)(lds + (bufoff) + ldsw + _i * 8192), 16, 0, 0); } while (0)
#define PG8_LDA(dst, b, h) do { _Pragma("unroll") for (int m = 0; m < 4; ++m) _Pragma("unroll") for (int k = 0; k < 2; ++k) dst[m][k] = *(const LAS bf16x8*)(lds + PG8_SA(b, h) + aoff + m * 2048 + k * 1024); } while (0)
#define PG8_LDB(dst, b, h) do { _Pragma("unroll") for (int n = 0; n < 2; ++n) _Pragma("unroll") for (int k = 0; k < 2; ++k) dst[n][k] = *(const LAS bf16x8*)(lds + PG8_SB(b, h) + boff + n * 2048 + k * 1024); } while (0)
#define PG8_MMA(ai, bj, At, Bt) do { __builtin_amdgcn_s_setprio(1); _Pragma("unroll") for (int m = 0; m < 4; ++m) _Pragma("unroll") for (int n = 0; n < 2; ++n) _Pragma("unroll") for (int k = 0; k < 2; ++k) \
        acc[ai][bj][m][n] = __builtin_amdgcn_mfma_f32_16x16x32_bf16(Bt[n][k], At[m][k], acc[ai][bj][m][n], 0, 0, 0); __builtin_amdgcn_s_setprio(0); } while (0)
#define PG8_WAIT_V(n) asm volatile("s_waitcnt vmcnt(" #n ")" ::: "memory")
#define PG8_WAIT_L(n) asm volatile("s_waitcnt lgkmcnt(" #n ")" ::: "memory")
#define PG8_BAR __builtin_amdgcn_s_barrier()
#define PG8_SCHED __builtin_amdgcn_sched_barrier(0)
    Unit cur, nxt; int ui = 0;
    if (!S.next(0, cur)) return;
    f32x4 acc[2][2][4][2];
#pragma unroll
    for (int a = 0; a < 2; ++a)
#pragma unroll
        for (int b = 0; b < 2; ++b)
#pragma unroll
            for (int m = 0; m < 4; ++m)
#pragma unroll
                for (int n = 0; n < 2; ++n) acc[a][b][m][n] = (f32x4){0.f, 0.f, 0.f, 0.f};
    bf16x8 At[4][2], B0[2][2], B1[2][2];
    const char* cA = (const char*)g.A + (size_t)cur.pm * tstep; const char* cB = (const char*)g.Bt + (size_t)cur.pn * tstep;
    PG8_STAGE(PG8_SB(0, 0), cB, voffB); PG8_STAGE(PG8_SA(0, 0), cA, voffA); PG8_STAGE(PG8_SB(0, 1), cB + hstepB, voffB); PG8_STAGE(PG8_SA(0, 1), cA + hstep, voffA);
    if (wr == 1) PG8_BAR;
    PG8_WAIT_V(4); PG8_BAR;
    PG8_STAGE(PG8_SB(1, 0), cB + kstep, voffB); PG8_STAGE(PG8_SA(1, 0), cA + kstep, voffA); PG8_STAGE(PG8_SB(1, 1), cB + hstepB + kstep, voffB);
    PG8_WAIT_V(6); PG8_BAR;
    for (;;) {
        const bool has_next = S.next(ui + 1, nxt);
        const char* nA = has_next ? (const char*)g.A + (size_t)nxt.pm * tstep : cA; const char* nB = has_next ? (const char*)g.Bt + (size_t)nxt.pn * tstep : cB;
#pragma unroll 1
        for (int t = 0; t < nt; t += 2) {
            const bool last = (t == nt - 2);
            const char* a1 = cA + (size_t)(t + 1) * kstep;
            const char* a2 = last ? nA : cA + (size_t)(t + 2) * kstep; const char* b2 = last ? nB : cB + (size_t)(t + 2) * kstep;
            const char* a3 = a2 + kstep; const char* b3 = b2 + kstep;
            PG8_LDB(B0, 0, 0); PG8_SCHED; PG8_LDA(At, 0, 0); PG8_STAGE(PG8_SA(1, 1), a1 + hstep, voffA);
            PG8_WAIT_L(8); PG8_BAR; PG8_WAIT_L(0); PG8_MMA(0, 0, At, B0); PG8_BAR; PG8_SCHED;
            PG8_LDB(B1, 0, 1); PG8_STAGE(PG8_SB(0, 0), b2, voffB);
            PG8_BAR; PG8_WAIT_L(0); PG8_MMA(0, 1, At, B1); PG8_BAR;
            PG8_LDA(At, 0, 1); PG8_STAGE(PG8_SA(0, 0), a2, voffA);
            PG8_BAR; PG8_WAIT_L(0); PG8_MMA(1, 0, At, B0); PG8_BAR; PG8_SCHED;
            PG8_STAGE(PG8_SB(0, 1), b2 + hstepB, voffB);
            PG8_WAIT_V(6); PG8_BAR; PG8_MMA(1, 1, At, B1); PG8_BAR;
            PG8_LDB(B0, 1, 0); PG8_SCHED; PG8_LDA(At, 1, 0); PG8_STAGE(PG8_SA(0, 1), a2 + hstep, voffA);
            PG8_WAIT_L(8); PG8_BAR; PG8_WAIT_L(0); PG8_MMA(0, 0, At, B0); PG8_BAR; PG8_SCHED;
            PG8_LDB(B1, 1, 1); PG8_STAGE(PG8_SB(1, 0), b3, voffB);
            PG8_BAR; PG8_WAIT_L(0); PG8_MMA(0, 1, At, B1); PG8_BAR;
            PG8_LDA(At, 1, 1); PG8_STAGE(PG8_SA(1, 0), a3, voffA);
            PG8_BAR; PG8_WAIT_L(0); PG8_MMA(1, 0, At, B0); PG8_BAR; PG8_SCHED;
            PG8_STAGE(PG8_SB(1, 1), b3 + hstepB, voffB);
            PG8_WAIT_V(6); PG8_BAR; PG8_MMA(1, 1, At, B1); PG8_BAR;
        }
        E(acc, cur, wr, wc, fr, fq);
        if (!has_next) break;
#pragma unroll
        for (int a = 0; a < 2; ++a)
#pragma unroll
            for (int b = 0; b < 2; ++b)
#pragma unroll
                for (int m = 0; m < 4; ++m)
#pragma unroll
                    for (int n = 0; n < 2; ++n) acc[a][b][m][n] = (f32x4){0.f, 0.f, 0.f, 0.f};
        cur = nxt; cA = nA; cB = nB; ++ui;
    }
    PG8_WAIT_V(0);
    if (wr == 0) PG8_BAR;
    PG8_BAR;
#undef PG8_SA
#undef PG8_SB
#undef PG8_STAGE
#undef PG8_LDA
#undef PG8_LDB
#undef PG8_MMA
#undef PG8_WAIT_V
#undef PG8_WAIT_L
#undef PG8_BAR
#undef PG8_SCHED
}
}
using pg8::Unit;
typedef f32x4 AccT[2][2][4][2];

struct EpiIn {
    static constexpr bool PERM = true, HEADMAP = true;
    bf16_t* QKV; bf16_t* PR; const float* qg; const float* kg;
    __device__ __forceinline__ void operator()(const AccT& acc, const Unit& u, int wr, int wc, int fr, int fq) const {
        const int row0 = u.pm * 256 + wr * 64 + fr;
        bf16_t* base; int ldc, colt, lim;
        if (u.pn < 6) { base = QKV; ldc = 1536; colt = u.pn * 256; lim = 1536; } else { base = PR; ldc = 1920; colt = (u.pn - 6) * 256; lim = 1920; }
        const int col0 = colt + wc * 64 + 8 * fq;
        const bool nrm = u.pn < 4;
        f32x4 g4[2][2];
        if (nrm) { const float* gp = (u.pn < 2 ? qg : kg) + 8 * fq;
#pragma unroll
            for (int bj = 0; bj < 2; ++bj)
#pragma unroll
                for (int n = 0; n < 2; ++n) g4[bj][n] = *(const f32x4*)(gp + 32 * bj + 4 * n); }
        const float qs = u.pn < 2 ? 0.125f : 1.f;
#pragma unroll
        for (int ai = 0; ai < 2; ++ai)
#pragma unroll
            for (int m = 0; m < 4; ++m) { bf16_t* rowp = base + (size_t)(row0 + ai * 128 + m * 16) * ldc + col0;
                f32x4 v[2][2];
#pragma unroll
                for (int bj = 0; bj < 2; ++bj)
#pragma unroll
                    for (int n = 0; n < 2; ++n) v[bj][n] = acc[ai][bj][m][n];
                if (nrm) {
                    float ss = 0.f;
#pragma unroll
                    for (int bj = 0; bj < 2; ++bj)
#pragma unroll
                        for (int n = 0; n < 2; ++n) ss += v[bj][n][0] * v[bj][n][0] + v[bj][n][1] * v[bj][n][1] + v[bj][n][2] * v[bj][n][2] + v[bj][n][3] * v[bj][n][3];
                    ss += __shfl_xor(ss, 16); ss += __shfl_xor(ss, 32);
                    const float sc = rsqrtf(ss * (1.f / 64.f) + NORM_EPS) * qs;
#pragma unroll
                    for (int bj = 0; bj < 2; ++bj)
#pragma unroll
                        for (int n = 0; n < 2; ++n) v[bj][n] = v[bj][n] * sc * g4[bj][n];
                }
#pragma unroll
                for (int bj = 0; bj < 2; ++bj) {
                    u32x4 w; w.x = cvt_pk_bf16(v[bj][0][0], v[bj][0][1]); w.y = cvt_pk_bf16(v[bj][0][2], v[bj][0][3]); w.z = cvt_pk_bf16(v[bj][1][0], v[bj][1][1]); w.w = cvt_pk_bf16(v[bj][1][2], v[bj][1][3]);
                    if (col0 + bj * 32 < lim) *(u32x4*)(rowp + bj * 32) = w; } }
    }
};
struct EpiLora {
    static constexpr bool PERM = true, HEADMAP = false;
    bf16_t* LORA; bf16_t* G; const float* w0; const float* a0;
    __device__ __forceinline__ void operator()(const AccT& acc, const Unit& u, int wr, int wc, int fr, int fq) const {
        const int row0 = u.pm * 256 + wr * 64 + fr;
        bf16_t* base; int ldc, colt; const bool isg = u.pn >= 8;
        if (!isg) { base = LORA; ldc = 2048; colt = u.pn * 256; } else { base = G; ldc = 512; colt = (u.pn - 8) * 256; }
        const int col0 = colt + wc * 32 + 8 * fq;
#pragma unroll
        for (int bj = 0; bj < 2; ++bj) {
#pragma unroll
            for (int ai = 0; ai < 2; ++ai)
#pragma unroll
                for (int m = 0; m < 4; ++m) { bf16_t* rowp = base + (size_t)(row0 + ai * 128 + m * 16) * ldc + col0 + bj * 128;
                    const f32x4 v0 = acc[ai][bj][m][0], v1 = acc[ai][bj][m][1];
                    u32x4 w; w.x = cvt_pk_bf16(v0[0], v0[1]); w.y = cvt_pk_bf16(v0[2], v0[3]); w.z = cvt_pk_bf16(v1[0], v1[1]); w.w = cvt_pk_bf16(v1[2], v1[3]);
                    *(u32x4*)rowp = w; }
        }
    }
};
struct EpiFf1 {
    static constexpr bool PERM = true, HEADMAP = false;
    bf16_t* HID;
    __device__ __forceinline__ void operator()(const AccT& acc, const Unit& u, int wr, int wc, int fr, int fq) const {
        const int row0 = u.pm * 256 + wr * 64 + fr;
        const int col0 = u.pn * 256 + wc * 32 + 8 * fq;
#pragma unroll
        for (int ai = 0; ai < 2; ++ai)
#pragma unroll
            for (int m = 0; m < 4; ++m) { bf16_t* rowp = HID + (size_t)(row0 + ai * 128 + m * 16) * DFF + col0;
#pragma unroll
                for (int bj = 0; bj < 2; ++bj) { f32x4 v0 = acc[ai][bj][m][0], v1 = acc[ai][bj][m][1];
#pragma unroll
                    for (int j = 0; j < 4; ++j) { const float a = fmaxf(v0[j], 0.f), b = fmaxf(v1[j], 0.f); v0[j] = a * a; v1[j] = b * b; }
                    u32x4 w; w.x = cvt_pk_bf16(v0[0], v0[1]); w.y = cvt_pk_bf16(v0[2], v0[3]); w.z = cvt_pk_bf16(v1[0], v1[1]); w.w = cvt_pk_bf16(v1[2], v1[3]);
                    *(u32x4*)(rowp + bj * 128) = w; } }
    }
};
struct EpiRes {
    static constexpr bool PERM = false, HEADMAP = false;
    float* out; const float* xp; const float* xs; const float* mod; int gate_off;
    __device__ __forceinline__ void operator()(const AccT& acc, const Unit& u, int wr, int wc, int fr, int fq) const {
        const int row0 = u.pm * 256 + wr * 64 + fr, col0 = u.pn * 256 + wc * 32 + 4 * fq;
        const int sq = seq_of_row(u.pm * 256);
        const float* gp = mod + (size_t)sq * 6144 + gate_off + col0;
        f32x4 gv[2][2];
#pragma unroll
        for (int bj = 0; bj < 2; ++bj)
#pragma unroll
            for (int n = 0; n < 2; ++n) gv[bj][n] = *(const f32x4*)(gp + bj * 128 + n * 16);
#pragma unroll
        for (int ai = 0; ai < 2; ++ai)
#pragma unroll
            for (int m = 0; m < 4; ++m) { const int row = row0 + ai * 128 + m * 16;
                float* op = out + (size_t)row * DM + col0;
                const float* rp = xp ? (row < NP ? xp + (size_t)row * DM : xs + (size_t)(row - NP) * DM) + col0 : op;
#pragma unroll
                for (int bj = 0; bj < 2; ++bj)
#pragma unroll
                    for (int n = 0; n < 2; ++n) { const f32x4 r = *(const f32x4*)(rp + bj * 128 + n * 16);
                        *(f32x4*)(op + bj * 128 + n * 16) = r + gv[bj][n] * acc[ai][bj][m][n]; } }
    }
};

__device__ void xpose_tile(LAS float* tile, const float* W, int N, int K, int k0, int n0, bf16_t* Wt) {
    const int tid = threadIdx.x;
#pragma unroll
    for (int i = 0; i < 8; ++i) { const int kk = (tid >> 6) + 8 * i, nn = tid & 63; tile[kk * 65 + nn] = W[(size_t)(k0 + kk) * N + n0 + nn]; }
    __syncthreads();
#pragma unroll
    for (int i = 0; i < 8; ++i) { const int nn = (tid >> 6) + 8 * i, kk = tid & 63; Wt[(size_t)(n0 + nn) * K + k0 + kk] = f2bf(tile[kk * 65 + nn]); }
    __syncthreads();
}
__device__ void phase_prep_weights(const Args& a, LAS unsigned char* lds) {
    LAS float* tile = (LAS float*)lds;
    bf16_t* WIN = (bf16_t*)(a.ws + OFF_WIN); bf16_t* WOUT = (bf16_t*)(a.ws + OFF_WOUT); bf16_t* WFF1 = (bf16_t*)(a.ws + OFF_WFF1); bf16_t* WFF2 = (bf16_t*)(a.ws + OFF_WFF2); bf16_t* WL = (bf16_t*)(a.ws + OFF_WL);
    for (int t = blockIdx.x; t < 3168; t += gridDim.x) {
        if (t < 864) { const int kt = t / 54, ntl = t % 54; xpose_tile(tile, a.in[I_WIN], NIN, 1024, kt * 64, ntl * 64, WIN); }
        else if (t < 1120) { const int u = t - 864; xpose_tile(tile, a.in[I_WOUT], 1024, 1024, (u / 16) * 64, (u % 16) * 64, WOUT); }
        else if (t < 2144) { const int u = t - 1120; xpose_tile(tile, a.in[I_WFF1], 4096, 1024, (u / 64) * 64, (u % 64) * 64, WFF1); }
        else { const int u = t - 2144; xpose_tile(tile, a.in[I_WFF2], 1024, 4096, (u / 16) * 64, (u % 16) * 64, WFF2); }
    }
    const int gtid = blockIdx.x * 512 + threadIdx.x, gn = gridDim.x * 512;
    if (gtid < 64) ((int*)(a.ws + OFF_FLAG))[gtid] = 0;
    for (int i = gtid; i < 128 * 1024; i += gn) WIN[(size_t)NIN * 1024 + i] = 0;
    for (int i = gtid; i < 2560 * 384; i += gn) {
        const int n = i / 384, kc = i % 384; float v = 0.f;
        if (n < 512) { if (kc < 64) v = a.in[I_WUP][(size_t)(0 * 64 + kc) * 512 + n]; }
        else if (n < 1024) { if (kc >= 64 && kc < 128) v = a.in[I_WUP][(size_t)(1 * 64 + kc - 64) * 512 + (n - 512)]; }
        else if (n < 1536) { if (kc >= 128 && kc < 192) v = a.in[I_AUP][(size_t)(0 * 64 + kc - 128) * 512 + (n - 1024)]; }
        else if (n < 2048) { if (kc >= 192 && kc < 256) v = a.in[I_AUP][(size_t)(1 * 64 + kc - 192) * 512 + (n - 1536)]; }
        else { if (kc >= 256) v = a.in[I_GUP][(size_t)(kc - 256) * 512 + (n - 2048)]; }
        WL[i] = f2bf(v);
    }
}
__device__ void phase_mod(const Args& a, LAS unsigned char* lds) {
    float* MOD = (float*)(a.ws + OFF_MOD);
    const int wave = threadIdx.x >> 6, lane = threadIdx.x & 63;
    LAS float* sl = (LAS float*)lds + wave * (64 * 36);
    for (int it = blockIdx.x; it < 96; it += gridDim.x) {
        const int j0 = it * 64;
        float acc[36];
#pragma unroll
        for (int b = 0; b < 36; ++b) acc[b] = 0.f;
        for (int half = 0; half < 2; ++half) {
            const int k0 = wave * 128 + half * 64;
#pragma unroll 1
            for (int b = 0; b < 36; ++b) { float sv = 0.f;
                if (b < NSEQ) { const float c = (b == 0) ? a.in[I_CP][k0 + lane] : a.in[I_CS][(size_t)(b - 1) * DM + k0 + lane]; sv = c / (1.f + __expf(-c)); }
                sl[lane * 36 + b] = sv; }
            asm volatile("s_waitcnt lgkmcnt(0)" ::: "memory");
#pragma unroll 1
            for (int k = 0; k < 64; ++k) { const float wv = a.in[I_WADA][(size_t)(k0 + k) * 6144 + j0 + lane];
                const LAS f32x4* sp = (const LAS f32x4*)(sl + k * 36);
#pragma unroll
                for (int q = 0; q < 9; ++q) { const f32x4 s4 = sp[q]; acc[4 * q] += s4[0] * wv; acc[4 * q + 1] += s4[1] * wv; acc[4 * q + 2] += s4[2] * wv; acc[4 * q + 3] += s4[3] * wv; } }
            asm volatile("s_waitcnt lgkmcnt(0)" ::: "memory");
        }
        __syncthreads();
        LAS float* ex = (LAS float*)lds;
#pragma unroll
        for (int b = 0; b < NSEQ; ++b) ex[wave * (NSEQ * 64) + b * 64 + lane] = acc[b];
        __syncthreads();
        for (int idx = threadIdx.x; idx < NSEQ * 64; idx += 512) { float sm = a.in[I_BADA][j0 + (idx & 63)];
#pragma unroll
            for (int w = 0; w < 8; ++w) sm += ex[w * (NSEQ * 64) + idx];
            MOD[(size_t)(idx >> 6) * 6144 + j0 + (idx & 63)] = sm; }
        __syncthreads();
    }
}

__device__ void phase_norm(const Args& a, const float* xp, const float* xs, const float* g, int sh_off, int sc_off) {
    const float* MOD = (const float*)(a.ws + OFF_MOD); bf16_t* H = (bf16_t*)(a.ws + OFF_H);
    const int wave = threadIdx.x >> 6, lane = threadIdx.x & 63;
    for (int row = blockIdx.x * 8 + wave; row < NTOK; row += gridDim.x * 8) {
        const float* xr = (row < NP) ? xp + (size_t)row * DM : xs + (size_t)(row - NP) * DM;
        const float* mr = MOD + (size_t)seq_of_row(row) * 6144;
        f32x4 v[4]; float ss = 0.f;
#pragma unroll
        for (int i = 0; i < 4; ++i) { v[i] = *(const f32x4*)(xr + i * 256 + lane * 4); ss += v[i][0] * v[i][0] + v[i][1] * v[i][1] + v[i][2] * v[i][2] + v[i][3] * v[i][3]; }
        ss = wave_sum(ss);
        const float rinv = rsqrtf(ss * (1.f / DM) + NORM_EPS);
#pragma unroll
        for (int i = 0; i < 4; ++i) { const int c = i * 256 + lane * 4;
            const f32x4 gg = *(const f32x4*)(g + c), sc = *(const f32x4*)(mr + sc_off + c), sh = *(const f32x4*)(mr + sh_off + c);
            f32x4 h;
#pragma unroll
            for (int j = 0; j < 4; ++j) h[j] = v[i][j] * rinv * gg[j] * (1.f + sc[j]) + sh[j];
            u32x2 w; w.x = cvt_pk_bf16(h[0], h[1]); w.y = cvt_pk_bf16(h[2], h[3]);
            *(u32x2*)(H + (size_t)row * DM + c) = w; }
    }
}

__device__ void phase_post_in(const Args& a) {
    const bf16_t* PR = (const bf16_t*)(a.ws + OFF_PR); bf16_t* X5 = (bf16_t*)(a.ws + OFF_X5);
    const int wave = threadIdx.x >> 6, lane = threadIdx.x & 63;
    const int c0 = (lane < 48 ? lane : 0) * 8;
    float mp[8], mn[8];
#pragma unroll
    for (int j = 0; j < 8; ++j) { mp[j] = a.in[I_MUP][1536 + c0 + j]; mn[j] = a.in[I_MUN][1536 + c0 + j]; }
    const int nw = gridDim.x * 8;
    for (int row = blockIdx.x * 8 + wave; row < NTOK; row += 2 * nw) {
        const int row2 = (row + nw < NTOK) ? row + nw : row;
        u32x4 cu[2], pv[2], nx[2]; int rr[2]; rr[0] = row; rr[1] = row2;
#pragma unroll
        for (int q = 0; q < 2; ++q) { const int r = rr[q];
            int pos, S; if (r < NP) { pos = r; S = NP; } else { pos = (r - NP) % SS; S = SS; }
            const bf16_t* pr = PR + (size_t)r * 1920 + 1536 + c0;
            cu[q] = *(const u32x4*)pr;
            pv[q] = pos > 0 ? *(const u32x4*)(pr - 1920) : (u32x4){0u, 0u, 0u, 0u};
            nx[q] = pos < S - 1 ? *(const u32x4*)(pr + 1920) : (u32x4){0u, 0u, 0u, 0u}; }
#pragma unroll
        for (int q = 0; q < 2; ++q) {
            if (q == 1 && row2 == row) break;
            float x[8];
#pragma unroll
            for (int j = 0; j < 4; ++j) { const float c_lo = lo_bf(cu[q][j]), c_hi = hi_bf(cu[q][j]);
                x[2 * j] = c_lo + mp[2 * j] * (lo_bf(pv[q][j]) - c_lo) + mn[2 * j] * (lo_bf(nx[q][j]) - c_lo);
                x[2 * j + 1] = c_hi + mp[2 * j + 1] * (hi_bf(pv[q][j]) - c_hi) + mn[2 * j + 1] * (hi_bf(nx[q][j]) - c_hi); }
            if (lane < 16) {
#pragma unroll
                for (int j = 0; j < 8; ++j) x[j] = tanhf(x[j]);
            } else if (lane >= 32) {
#pragma unroll
                for (int j = 0; j < 8; ++j) x[j] = 1.f / (1.f + __expf(-x[j]));
            }
            u32x4 w; w.x = cvt_pk_bf16(x[0], x[1]); w.y = cvt_pk_bf16(x[2], x[3]); w.z = cvt_pk_bf16(x[4], x[5]); w.w = cvt_pk_bf16(x[6], x[7]);
            if (lane < 48) *(u32x4*)(X5 + (size_t)rr[q] * 384 + c0) = w;
        }
    }
}

__device__ void attn_job4(const Args& a, LAS bf16_t* vlb, int row0, int S, int h, int q0a, float cshift) {
    const bf16_t* QKV = (const bf16_t*)a.out; bf16_t* MIX = (bf16_t*)(a.ws + OFF_H);
    const int lane = threadIdx.x & 63, fr = lane & 15, g = lane >> 4;
    const float slope = exp2f(-(float)(h + 1));
    constexpr int VP = 64;
    const bf16_t* kbase = QKV + (size_t)row0 * 1536 + 512 + h * 64 + g * 8;
    const bf16_t* vbase = QKV + (size_t)row0 * 1536 + 1024 + h * 64;
    int qp[4]; f32x4 O[4][4]; float l[4];
    LAS bf16x8* qlds = (LAS bf16x8*)(vlb + 2 * 32 * VP);
    asm volatile("s_waitcnt lgkmcnt(0)" ::: "memory");
#pragma unroll
    for (int jj = 0; jj < 4; ++jj) { qp[jj] = q0a + 4 * jj + 16 * fr;
        const bf16_t* qrow = QKV + (size_t)(row0 + qp[jj]) * 1536 + h * 64;
        qlds[(jj * 2 + 0) * 64 + lane] = *(const bf16x8*)(qrow + g * 8); qlds[(jj * 2 + 1) * 64 + lane] = *(const bf16x8*)(qrow + 32 + g * 8); l[jj] = 0.f;
#pragma unroll
        for (int i = 0; i < 4; ++i) O[jj][i] = (f32x4){0.f, 0.f, 0.f, 0.f}; }
    bf16x8 nka0[2], nka1[2], nkb0[2], nkb1[2]; u32x4 nvv[2][4];
    const float slope2 = slope * 1.44269504f, c2 = cshift * 1.44269504f;
    const unsigned traddr = (unsigned)(unsigned long)vlb + (unsigned)((8 * g + ((lane & 15) >> 2)) * (VP * 2) + 8 * (lane & 3));
#define LOAD_SET(KJ, Q0S, D_, TP_) { const int base_ = (Q0S) - 64 * (D_); \
        int kpa = base_ + (D_) * (16 * (TP_) + fr), kpb = kpa + 16 * (D_); kpa = min(max(kpa, 0), S - 1); kpb = min(max(kpb, 0), S - 1); \
        const bf16_t* ka = kbase + (size_t)kpa * 1536; const bf16_t* kb = kbase + (size_t)kpb * 1536; \
        nka0[KJ] = *(const bf16x8*)ka; nka1[KJ] = *(const bf16x8*)(ka + 32); nkb0[KJ] = *(const bf16x8*)kb; nkb1[KJ] = *(const bf16x8*)(kb + 32); \
        _Pragma("unroll") for (int i = 0; i < 4; ++i) { const int idx = lane + 64 * i, rr = idx >> 3, chk = idx & 7; \
            int kp = base_ + (D_) * (16 * (TP_) + rr); kp = min(max(kp, 0), S - 1); nvv[KJ][i] = *(const u32x4*)(vbase + (size_t)kp * 1536 + chk * 8); } }
#define V_TO_LDS(KJ) _Pragma("unroll") for (int i = 0; i < 4; ++i) { const int idx = lane + 64 * i, rr = idx >> 3, chk = idx & 7; \
            const int rho = 8 * ((rr & 15) >> 2) + 4 * (rr >> 4) + (rr & 3); \
            *(LAS u32x4*)(vlb + (KJ) * (32 * VP) + rho * VP + chk * 8) = nvv[KJ][i]; }
#define QK_SOFTMAX(JJ, KJ, SHIFT, D_, TP_, PF) { \
        const bf16x8 q0_ = qlds[((JJ) * 2 + 0) * 64 + lane], q1_ = qlds[((JJ) * 2 + 1) * 64 + lane]; \
        f32x4 sa_ = __builtin_amdgcn_mfma_f32_16x16x32_bf16(nka0[KJ], q0_, (f32x4){0.f, 0.f, 0.f, 0.f}, 0, 0, 0); sa_ = __builtin_amdgcn_mfma_f32_16x16x32_bf16(nka1[KJ], q1_, sa_, 0, 0, 0); \
        f32x4 sb_ = __builtin_amdgcn_mfma_f32_16x16x32_bf16(nkb0[KJ], q0_, (f32x4){0.f, 0.f, 0.f, 0.f}, 0, 0, 0); sb_ = __builtin_amdgcn_mfma_f32_16x16x32_bf16(nkb1[KJ], q1_, sb_, 0, 0, 0); \
        const float fd_ = (float)(D_); \
        const float fR0 = (float)((D_) * (16 * (TP_) + 4 * g - 64) - 16 * fr) - (float)(SHIFT); \
        const float lo = fmaxf(-64.f * fd_, -(float)qp[JJ]), hi = fminf(64.f * fd_, (float)(S - 1 - qp[JJ])); \
        float pa[4], pb[4]; \
        _Pragma("unroll") for (int j = 0; j < 4; ++j) { \
            const float r1 = fR0 + (float)j * fd_, r2 = r1 + 16.f * fd_; \
            const float e1 = __builtin_amdgcn_exp2f(__builtin_fmaf(-slope2, fabsf(r1), __builtin_fmaf(sa_[j], 1.44269504f, -c2))); \
            const float e2 = __builtin_amdgcn_exp2f(__builtin_fmaf(-slope2, fabsf(r2), __builtin_fmaf(sb_[j], 1.44269504f, -c2))); \
            pa[j] = (r1 >= lo && r1 <= hi) ? e1 : 0.f; pb[j] = (r2 >= lo && r2 <= hi) ? e2 : 0.f; \
            l[JJ] += pa[j] + pb[j]; } \
        u32x4 pw; pw.x = cvt_pk_bf16(pa[0], pa[1]); pw.y = cvt_pk_bf16(pa[2], pa[3]); pw.z = cvt_pk_bf16(pb[0], pb[1]); pw.w = cvt_pk_bf16(pb[2], pb[3]); \
        __builtin_memcpy(&PF, &pw, 16); }
#define TR_READ2(KJ, DB0, TV) { _Pragma("unroll") for (int db = 0; db < 2; ++db) _Pragma("unroll") for (int t = 0; t < 2; ++t) \
            asm volatile("ds_read_b64_tr_b16 %0, %1" : "=v"(TV[db][t]) : "v"(traddr + (unsigned)((KJ) * (32 * VP * 2) + t * (4 * VP * 2) + ((DB0) + db) * 32))); \
        asm volatile("s_waitcnt lgkmcnt(0)" : "+v"(TV[0][0]), "+v"(TV[0][1]), "+v"(TV[1][0]), "+v"(TV[1][1]) :: "memory"); }
#define PV2(JJ, DB0, TV, PF) _Pragma("unroll") for (int db = 0; db < 2; ++db) { \
            u32x4 vw; vw.x = TV[db][0].x; vw.y = TV[db][0].y; vw.z = TV[db][1].x; vw.w = TV[db][1].y; \
            bf16x8 vf; __builtin_memcpy(&vf, &vw, 16); \
            O[JJ][(DB0) + db] = __builtin_amdgcn_mfma_f32_16x16x32_bf16(vf, PF, O[JJ][(DB0) + db], 0, 0, 0); }
    LOAD_SET(0, q0a, 1, 0)
    for (int st = 0; st < 18; ++st) {
        const int d = st < 12 ? 1 : 4, tp = st < 12 ? 2 * st : 2 * (st - 12);
        bf16x8 pf0, pf1, pf2, pf3;
        QK_SOFTMAX(0, 0, 0, d, tp, pf0) QK_SOFTMAX(1, 0, 4, d, tp, pf1) QK_SOFTMAX(2, 0, 8, d, tp, pf2) QK_SOFTMAX(3, 0, 12, d, tp, pf3)
        asm volatile("s_waitcnt lgkmcnt(0)" ::: "memory");
        V_TO_LDS(0)
        asm volatile("" ::: "memory");
        if (st + 1 < 18) { const int sn = st + 1, dn = sn < 12 ? 1 : 4, tn = sn < 12 ? 2 * sn : 2 * (sn - 12); LOAD_SET(0, q0a, dn, tn) }
        else { LOAD_SET(0, q0a, 16, 0) }
        asm volatile("s_waitcnt lgkmcnt(0)" ::: "memory");
        u32x2 tv[2][2];
        TR_READ2(0, 0, tv) PV2(0, 0, tv, pf0) PV2(1, 0, tv, pf1) PV2(2, 0, tv, pf2) PV2(3, 0, tv, pf3)
        TR_READ2(0, 2, tv) PV2(0, 2, tv, pf0) PV2(1, 2, tv, pf1) PV2(2, 2, tv, pf2) PV2(3, 2, tv, pf3)
    }
    LOAD_SET(1, q0a + 4, 16, 0)
    for (int s5 = 0; s5 < 5; ++s5) {
        const int tp = 2 * s5;
        {   bf16x8 pfa, pfb;
            QK_SOFTMAX(0, 0, 0, 16, tp, pfa) QK_SOFTMAX(1, 1, 0, 16, tp, pfb)
            asm volatile("s_waitcnt lgkmcnt(0)" ::: "memory");
            V_TO_LDS(0) V_TO_LDS(1)
            asm volatile("" ::: "memory");
            LOAD_SET(0, q0a + 8, 16, tp) LOAD_SET(1, q0a + 12, 16, tp)
            asm volatile("s_waitcnt lgkmcnt(0)" ::: "memory");
            u32x2 tv[2][2];
            TR_READ2(0, 0, tv) PV2(0, 0, tv, pfa) TR_READ2(0, 2, tv) PV2(0, 2, tv, pfa)
            TR_READ2(1, 0, tv) PV2(1, 0, tv, pfb) TR_READ2(1, 2, tv) PV2(1, 2, tv, pfb) }
        {   bf16x8 pfa, pfb;
            QK_SOFTMAX(2, 0, 0, 16, tp, pfa) QK_SOFTMAX(3, 1, 0, 16, tp, pfb)
            asm volatile("s_waitcnt lgkmcnt(0)" ::: "memory");
            V_TO_LDS(0) V_TO_LDS(1)
            asm volatile("" ::: "memory");
            { const int tn = s5 < 4 ? tp + 2 : tp; LOAD_SET(0, q0a, 16, tn) LOAD_SET(1, q0a + 4, 16, tn) }
            asm volatile("s_waitcnt lgkmcnt(0)" ::: "memory");
            u32x2 tv[2][2];
            TR_READ2(0, 0, tv) PV2(2, 0, tv, pfa) TR_READ2(0, 2, tv) PV2(2, 2, tv, pfa)
            TR_READ2(1, 0, tv) PV2(3, 0, tv, pfb) TR_READ2(1, 2, tv) PV2(3, 2, tv, pfb) }
    }
#undef LOAD_SET
#undef V_TO_LDS
#undef QK_SOFTMAX
#undef TR_READ2
#undef PV2
    const float* beta = a.in[I_BETA] + h * 64;
#pragma unroll
    for (int jj = 0; jj < 4; ++jj) {
        float ls = l[jj]; ls += __shfl_xor(ls, 16); ls += __shfl_xor(ls, 32);
        const float inv = 1.f / ls;
        bf16_t* op = MIX + (size_t)(row0 + qp[jj]) * DM + h * 64;
#pragma unroll
        for (int db = 0; db < 4; ++db) { const int dd = 16 * db + 4 * g;
            u32x2 w; w.x = cvt_pk_bf16(O[jj][db][0] * inv * beta[dd], O[jj][db][1] * inv * beta[dd + 1]); w.y = cvt_pk_bf16(O[jj][db][2] * inv * beta[dd + 2], O[jj][db][3] * inv * beta[dd + 3]);
            *(u32x2*)(op + dd) = w; }
    }
}
__device__ void phase_attn(const Args& a, LAS unsigned char* lds) {
    const int wave = threadIdx.x >> 6, lane = threadIdx.x & 63;
    LAS bf16_t* vl = (LAS bf16_t*)(lds + wave * 16384);
    const float gq = wave_max(fabsf(a.in[I_QG][lane])), gk = wave_max(fabsf(a.in[I_KG][lane]));
    const float cshift = 8.f * gq * gk;
    const int njobs = (NTOK / 256) * 8 * 4;
    for (int j = blockIdx.x * 8 + wave; j < njobs; j += gridDim.x * 8) {
        const int r = j & 3, h = (j >> 2) & 7, tb = j >> 5;
        const int rowb = tb * 256;
        int row0, S; if (rowb < NP) { row0 = 0; S = NP; } else { row0 = NP + ((rowb - NP) / SS) * SS; S = SS; }
        attn_job4(a, vl, row0, S, h, rowb - row0 + r, cshift);
    }
}

__device__ __forceinline__ float dpp_x1(float x) { return __int_as_float(__builtin_amdgcn_update_dpp(0, __float_as_int(x), 0xB1, 0xF, 0xF, true)); }
__device__ __forceinline__ float dpp_x2(float x) { return __int_as_float(__builtin_amdgcn_update_dpp(0, __float_as_int(x), 0x4E, 0xF, 0xF, true)); }
__device__ __forceinline__ float quad_sum(float x) { x += dpp_x1(x); x += dpp_x2(x); return x; }
constexpr int SEG = 256, NSEGP = NP / SEG;

template <int MODE>
__device__ void scan_job(const Args& a, LAS float* wl, int row0, int S, int h, int dir, int i0, int n, const float* startp, float* endp, bool emit) {
    const bf16_t* PR = (const bf16_t*)(a.ws + OFF_PR); const bf16_t* LORA = (const bf16_t*)(a.ws + OFF_LORA);
    bf16_t* Y = (bf16_t*)(a.ws + OFF_Y); float* CB = (float*)(a.ws + OFF_C);
    const int lane = threadIdx.x & 63, ch = h * 64 + lane, qd = lane >> 2, kq = lane & 3;
    const float mpr_r = a.in[I_MUP][ch], mnx_r = a.in[I_MUN][ch], mpr_k = a.in[I_MUP][512 + ch], mnx_k = a.in[I_MUN][512 + ch], mpr_v = a.in[I_MUP][1024 + ch], mnx_v = a.in[I_MUN][1024 + ch];
    const float kkc = a.in[I_KK][ch], kac = a.in[I_KA][ch], rkc = a.in[I_RK][ch];
    const float w0c = a.in[I_W0][dir * 512 + ch], a0c = a.in[I_A0][dir * 512 + ch];
    f32x2 St[4][8];
#pragma unroll
    for (int i = 0; i < 4; ++i)
#pragma unroll
        for (int k2 = 0; k2 < 8; ++k2) {
            if (MODE == 1) { const int r = 4 * qd + i, c = kq * 16 + 2 * k2; St[i][k2] = (f32x2){r == c ? 1.f : 0.f, r == c + 1 ? 1.f : 0.f}; }
            else if (startp) St[i][k2] = *(const f32x2*)(startp + (4 * qd + i) * 64 + kq * 16 + 2 * k2);
            else St[i][k2] = (f32x2){0.f, 0.f};
        }
    const int sd = dir ? -1 : 1;
    const int t0 = dir ? S - 1 - i0 : i0;
    float rb = 0.f, kb = 0.f, vb = 0.f, rc, kc, vc, ra = 0.f, ka = 0.f, va = 0.f;
    { const bf16_t* p = PR + (size_t)(row0 + t0) * 1920 + ch; rc = bf2f(p[0]); kc = bf2f(p[512]); vc = bf2f(p[1024]);
      const int tb = t0 - sd, ta = t0 + sd;
      if (tb >= 0 && tb < S) { const bf16_t* q = PR + (size_t)(row0 + tb) * 1920 + ch; rb = bf2f(q[0]); kb = bf2f(q[512]); vb = bf2f(q[1024]); }
      if (ta >= 0 && ta < S) { const bf16_t* q = PR + (size_t)(row0 + ta) * 1920 + ch; ra = bf2f(q[0]); ka = bf2f(q[512]); va = bf2f(q[1024]); } }
    bf16_t nr[4], nk[4], nv[4], lw[4], la[4];
#define SCAN_LOADS(IB, R_, K_, V_, W_, A_) _Pragma("unroll") for (int u = 0; u < 4; ++u) { const int t = t0 + sd * ((IB) + u), t2 = t + 2 * sd; const bool ok = (t2 >= 0 && t2 < S); \
            const bf16_t* p = PR + (size_t)(row0 + (ok ? t2 : t)) * 1920 + ch; \
            R_[u] = ok ? p[0] : (bf16_t)0; K_[u] = ok ? p[512] : (bf16_t)0; V_[u] = ok ? p[1024] : (bf16_t)0; \
            const bf16_t* lp = LORA + (size_t)(row0 + t) * 2048 + dir * 512 + ch; W_[u] = lp[0]; A_[u] = lp[1024]; }
    SCAN_LOADS(0, nr, nk, nv, lw, la)
    for (int ib = 0; ib < n; ib += 4) {
        bf16_t pr_[4], pk_[4], pv_[4], pw_[4], pa_[4];
        { const int ibn = (ib + 4 < n) ? ib + 4 : ib; SCAN_LOADS(ibn, pr_, pk_, pv_, pw_, pa_) }
#pragma unroll
        for (int u = 0; u < 4; ++u) {
            const int t = t0 + sd * (ib + u);
            const float rp = dir ? ra : rb, rn = dir ? rb : ra, kp = dir ? ka : kb, kn = dir ? kb : ka, vp = dir ? va : vb, vn = dir ? vb : va;
            const float r = rc + mpr_r * (rp - rc) + mnx_r * (rn - rc);
            const float k = kc + mpr_k * (kp - kc) + mnx_k * (kn - kc);
            const float v = vc + mpr_v * (vp - vc) + mnx_v * (vn - vc);
            const float wraw = bf2f(lw[u]) + w0c, apre = bf2f(la[u]) + a0c;
            const float w = __expf(-0.60653066f * __builtin_amdgcn_rcpf(1.f + __expf(-wraw)));
            const float av = __builtin_amdgcn_rcpf(1.f + __expf(-apre));
            const float kkr = k * kkc; const float ssq = wave_sum(kkr * kkr);
            const float kk = kkr * rsqrtf(fmaxf(ssq, 1e-24f));
            const float kd = k * (1.f + (av - 1.f) * kac);
            const float bb = kk * av;
            LAS float* o = wl + u * 384;
            o[lane] = w; o[64 + lane] = kk; o[128 + lane] = bb; o[192 + lane] = kd; o[256 + lane] = r; o[320 + lane] = v;
            if (emit) { const float cd = wave_sum(r * kd * rkc); if (lane == 0) CB[((size_t)dir * NTOK + row0 + t) * 8 + h] = cd; }
            rb = rc; kb = kc; vb = vc; rc = ra; kc = ka; vc = va; ra = bf2f(nr[u]); ka = bf2f(nk[u]); va = bf2f(nv[u]);
        }
        asm volatile("s_waitcnt lgkmcnt(0)" ::: "memory");
#pragma unroll
        for (int u = 0; u < 4; ++u) {
            const LAS f32x4* V4 = (const LAS f32x4*)(wl + u * 384);
            f32x4 k4[4];
#pragma unroll
            for (int j = 0; j < 4; ++j) k4[j] = V4[16 + kq * 4 + j];
            float sa[4];
#pragma unroll
            for (int i = 0; i < 4; ++i) { f32x2 a2 = (f32x2){0.f, 0.f};
#pragma unroll
                for (int j = 0; j < 4; ++j) { a2 += St[i][2 * j] * (f32x2){k4[j][0], k4[j][1]}; a2 += St[i][2 * j + 1] * (f32x2){k4[j][2], k4[j][3]}; }
                sa[i] = quad_sum(a2[0] + a2[1]); }
            f32x4 w4[4], b4[4], d4[4], r4[4];
#pragma unroll
            for (int j = 0; j < 4; ++j) { w4[j] = V4[kq * 4 + j]; b4[j] = V4[32 + kq * 4 + j]; if (MODE == 0) { d4[j] = V4[48 + kq * 4 + j]; r4[j] = V4[64 + kq * 4 + j]; } }
            f32x4 vr = (f32x4){0.f, 0.f, 0.f, 0.f};
            if (MODE == 0) vr = V4[80 + qd];
            float yv[4];
#pragma unroll
            for (int i = 0; i < 4; ++i) {
                const f32x2 nsa = (f32x2){-sa[i], -sa[i]}, vv2 = (f32x2){vr[i], vr[i]};
                f32x2 y2 = (f32x2){0.f, 0.f};
#pragma unroll
                for (int j = 0; j < 4; ++j) {
                    f32x2 ta = nsa * (f32x2){b4[j][0], b4[j][1]}, tb = nsa * (f32x2){b4[j][2], b4[j][3]};
                    if (MODE == 0) { ta += vv2 * (f32x2){d4[j][0], d4[j][1]}; tb += vv2 * (f32x2){d4[j][2], d4[j][3]}; }
                    St[i][2 * j] = St[i][2 * j] * (f32x2){w4[j][0], w4[j][1]} + ta; St[i][2 * j + 1] = St[i][2 * j + 1] * (f32x2){w4[j][2], w4[j][3]} + tb;
                    if (MODE == 0) { y2 += St[i][2 * j] * (f32x2){r4[j][0], r4[j][1]}; y2 += St[i][2 * j + 1] * (f32x2){r4[j][2], r4[j][3]}; }
                }
                yv[i] = y2[0] + y2[1];
            }
            if (MODE == 0 && emit) {
#pragma unroll
                for (int i = 0; i < 4; ++i) yv[i] = quad_sum(yv[i]);
                const int t = t0 + sd * (ib + u);
                if (kq == 0) { u32x2 w; w.x = cvt_pk_bf16(yv[0], yv[1]); w.y = cvt_pk_bf16(yv[2], yv[3]);
                    *(u32x2*)(Y + ((size_t)dir * NTOK + row0 + t) * 512 + h * 64 + 4 * qd) = w; }
            }
        }
        asm volatile("s_waitcnt lgkmcnt(0)" ::: "memory");
#pragma unroll
        for (int u = 0; u < 4; ++u) { nr[u] = pr_[u]; nk[u] = pk_[u]; nv[u] = pv_[u]; lw[u] = pw_[u]; la[u] = pa_[u]; }
    }
#undef SCAN_LOADS
    if (endp) {
#pragma unroll
        for (int i = 0; i < 4; ++i)
#pragma unroll
            for (int k2 = 0; k2 < 8; ++k2) *(f32x2*)(endp + (4 * qd + i) * 64 + kq * 16 + 2 * k2) = St[i][k2];
    }
}
__device__ __forceinline__ float* sum_slot(const Args& a, int chain, int seg, int which) { return (float*)(a.ws + OFF_SUM) + ((size_t)(chain * NSEGP + seg) * 2 + which) * 4096; }

__device__ void scan_job_pq(const Args& a, LAS float* wl, int row0, int S, int h, int dir, int i0, int n, int half, float* endP, float* endQ) {
    const bf16_t* PR = (const bf16_t*)(a.ws + OFF_PR); const bf16_t* LORA = (const bf16_t*)(a.ws + OFF_LORA);
    const int lane = threadIdx.x & 63, ch = h * 64 + lane, qd = lane >> 2, kq = lane & 3;
    const float mpr_k = a.in[I_MUP][512 + ch], mnx_k = a.in[I_MUN][512 + ch], mpr_v = a.in[I_MUP][1024 + ch], mnx_v = a.in[I_MUN][1024 + ch];
    const float kkc = a.in[I_KK][ch], kac = a.in[I_KA][ch];
    const float w0c = a.in[I_W0][dir * 512 + ch], a0c = a.in[I_A0][dir * 512 + ch];
    f32x2 Sp[2][8], Sq[2][8];
#pragma unroll
    for (int i = 0; i < 2; ++i)
#pragma unroll
        for (int k2 = 0; k2 < 8; ++k2) { const int r = 4 * qd + 2 * half + i, c = kq * 16 + 2 * k2; Sp[i][k2] = (f32x2){r == c ? 1.f : 0.f, r == c + 1 ? 1.f : 0.f}; Sq[i][k2] = (f32x2){0.f, 0.f}; }
    const int sd = dir ? -1 : 1;
    const int t0 = dir ? S - 1 - i0 : i0;
    float kb = 0.f, vb = 0.f, kc, vc, ka = 0.f, va = 0.f;
    { const bf16_t* p = PR + (size_t)(row0 + t0) * 1920 + ch; kc = bf2f(p[512]); vc = bf2f(p[1024]);
      const int tb = t0 - sd, ta = t0 + sd;
      if (tb >= 0 && tb < S) { const bf16_t* q = PR + (size_t)(row0 + tb) * 1920 + ch; kb = bf2f(q[512]); vb = bf2f(q[1024]); }
      if (ta >= 0 && ta < S) { const bf16_t* q = PR + (size_t)(row0 + ta) * 1920 + ch; ka = bf2f(q[512]); va = bf2f(q[1024]); } }
    bf16_t nk[4], nv[4], lw[4], la[4];
#define PQ_LOADS(IB, K_, V_, W_, A_) _Pragma("unroll") for (int u = 0; u < 4; ++u) { const int t = t0 + sd * ((IB) + u), t2 = t + 2 * sd; const bool ok = (t2 >= 0 && t2 < S); \
            const bf16_t* p = PR + (size_t)(row0 + (ok ? t2 : t)) * 1920 + ch; \
            K_[u] = ok ? p[512] : (bf16_t)0; V_[u] = ok ? p[1024] : (bf16_t)0; \
            const bf16_t* lp = LORA + (size_t)(row0 + t) * 2048 + dir * 512 + ch; W_[u] = lp[0]; A_[u] = lp[1024]; }
    PQ_LOADS(0, nk, nv, lw, la)
    for (int ib = 0; ib < n; ib += 4) {
        bf16_t pk_[4], pv_[4], pw_[4], pa_[4];
        { const int ibn = (ib + 4 < n) ? ib + 4 : ib; PQ_LOADS(ibn, pk_, pv_, pw_, pa_) }
#pragma unroll
        for (int u = 0; u < 4; ++u) {
            const float kp = dir ? ka : kb, kn = dir ? kb : ka, vp = dir ? va : vb, vn = dir ? vb : va;
            const float k = kc + mpr_k * (kp - kc) + mnx_k * (kn - kc);
            const float v = vc + mpr_v * (vp - vc) + mnx_v * (vn - vc);
            const float wraw = bf2f(lw[u]) + w0c, apre = bf2f(la[u]) + a0c;
            const float w = __expf(-0.60653066f * __builtin_amdgcn_rcpf(1.f + __expf(-wraw)));
            const float av = __builtin_amdgcn_rcpf(1.f + __expf(-apre));
            const float kkr = k * kkc; const float ssq = wave_sum(kkr * kkr);
            const float kk = kkr * rsqrtf(fmaxf(ssq, 1e-24f));
            const float kd = k * (1.f + (av - 1.f) * kac);
            const float bb = kk * av;
            LAS float* o = wl + u * 384;
            o[lane] = w; o[64 + lane] = kk; o[128 + lane] = bb; o[192 + lane] = kd; o[320 + lane] = v;
            kb = kc; vb = vc; kc = ka; vc = va; ka = bf2f(nk[u]); va = bf2f(nv[u]);
        }
        asm volatile("s_waitcnt lgkmcnt(0)" ::: "memory");
#pragma unroll
        for (int u = 0; u < 4; ++u) {
            const LAS f32x4* V4 = (const LAS f32x4*)(wl + u * 384);
            __builtin_amdgcn_sched_barrier(0);
            f32x4 k4[4], w4[4], b4[4], d4[4];
#pragma unroll
            for (int j = 0; j < 4; ++j) k4[j] = V4[16 + kq * 4 + j];
            float sap[2], saq[2];
#pragma unroll
            for (int i = 0; i < 2; ++i) { f32x2 ap = (f32x2){0.f, 0.f}, aq = (f32x2){0.f, 0.f};
#pragma unroll
                for (int j = 0; j < 4; ++j) { ap += Sp[i][2 * j] * (f32x2){k4[j][0], k4[j][1]}; ap += Sp[i][2 * j + 1] * (f32x2){k4[j][2], k4[j][3]};
                                              aq += Sq[i][2 * j] * (f32x2){k4[j][0], k4[j][1]}; aq += Sq[i][2 * j + 1] * (f32x2){k4[j][2], k4[j][3]}; }
                sap[i] = quad_sum(ap[0] + ap[1]); saq[i] = quad_sum(aq[0] + aq[1]); }
            __builtin_amdgcn_sched_barrier(0);
#pragma unroll
            for (int j = 0; j < 4; ++j) { w4[j] = V4[kq * 4 + j]; b4[j] = V4[32 + kq * 4 + j]; d4[j] = V4[48 + kq * 4 + j]; }
            const f32x4 vr = V4[80 + qd];
#pragma unroll
            for (int i = 0; i < 2; ++i) {
                const float vsel = half ? (i ? vr[3] : vr[2]) : (i ? vr[1] : vr[0]);
                const f32x2 nsp = (f32x2){-sap[i], -sap[i]}, nsq = (f32x2){-saq[i], -saq[i]}, vv2 = (f32x2){vsel, vsel};
#pragma unroll
                for (int j = 0; j < 4; ++j) {
                    const f32x2 blo = (f32x2){b4[j][0], b4[j][1]}, bhi = (f32x2){b4[j][2], b4[j][3]}, wlo = (f32x2){w4[j][0], w4[j][1]}, whi = (f32x2){w4[j][2], w4[j][3]};
                    Sp[i][2 * j] = Sp[i][2 * j] * wlo + nsp * blo; Sp[i][2 * j + 1] = Sp[i][2 * j + 1] * whi + nsp * bhi;
                    Sq[i][2 * j] = Sq[i][2 * j] * wlo + (vv2 * (f32x2){d4[j][0], d4[j][1]} + nsq * blo); Sq[i][2 * j + 1] = Sq[i][2 * j + 1] * whi + (vv2 * (f32x2){d4[j][2], d4[j][3]} + nsq * bhi);
                }
            }
        }
        asm volatile("s_waitcnt lgkmcnt(0)" ::: "memory");
#pragma unroll
        for (int u = 0; u < 4; ++u) { nk[u] = pk_[u]; nv[u] = pv_[u]; lw[u] = pw_[u]; la[u] = pa_[u]; }
    }
#undef PQ_LOADS
#pragma unroll
    for (int i = 0; i < 2; ++i)
#pragma unroll
        for (int k2 = 0; k2 < 8; ++k2) { *(f32x2*)(endP + (4 * qd + 2 * half + i) * 64 + kq * 16 + 2 * k2) = Sp[i][k2]; *(f32x2*)(endQ + (4 * qd + 2 * half + i) * 64 + kq * 16 + 2 * k2) = Sq[i][k2]; }
}
__device__ void phase_scan_pass1(const Args& a, LAS unsigned char* lds) {
    const int wave = threadIdx.x >> 6;
    LAS float* wl = (LAS float*)(lds + wave * 16384);
    const int njobs = 16 * (NSEGP - 1) * 2;
    for (int j = blockIdx.x * 8 + wave; j < njobs; j += gridDim.x * 8) {
        const int chain = j / ((NSEGP - 1) * 2), rem = j % ((NSEGP - 1) * 2), seg = rem >> 1, half = rem & 1;
        scan_job_pq(a, wl, 0, NP, chain >> 1, chain & 1, seg * SEG, SEG, half, sum_slot(a, chain, seg, 0), sum_slot(a, chain, seg, 1));
    }
}
__device__ void combine_chain(const Args& a, LAS unsigned char* lds, int chain, int q) {
    LAS float* Ss = (LAS float*)lds;
    LAS float* Ps = (LAS float*)(lds + 8192);
    const int tid = threadIdx.x, vl = tid >> 5, v = 16 * q + vl, kb = (tid & 31) * 2;
    { const float* q0 = sum_slot(a, chain, 0, 1);
      for (int i = tid; i < 1024; i += 512) Ss[(i >> 6) * 65 + (i & 63)] = q0[(16 * q + (i >> 6)) * 64 + (i & 63)]; }
    f32x4 np0, np1; f32x2 nc;
    { const float* pj = sum_slot(a, chain, 1, 0); const float* qj = sum_slot(a, chain, 1, 1);
      np0 = *(const f32x4*)(pj + tid * 4); np1 = *(const f32x4*)(pj + 2048 + tid * 4); nc = *(const f32x2*)(qj + v * 64 + kb); }
    for (int j = 1; j < NSEGP - 1; ++j) {
        float* qj = sum_slot(a, chain, j, 1);
        *(LAS f32x4*)(Ps + tid * 4) = np0; *(LAS f32x4*)(Ps + 2048 + tid * 4) = np1;
        f32x2 c = nc;
        if (j + 1 < NSEGP - 1) { const float* pn = sum_slot(a, chain, j + 1, 0); const float* qn = sum_slot(a, chain, j + 1, 1);
            np0 = *(const f32x4*)(pn + tid * 4); np1 = *(const f32x4*)(pn + 2048 + tid * 4); nc = *(const f32x2*)(qn + v * 64 + kb); }
        __syncthreads();
#pragma unroll 16
        for (int m = 0; m < 64; ++m) { const float sv = Ss[vl * 65 + m]; const f32x2 p = *(const LAS f32x2*)(Ps + m * 64 + kb); c += sv * p; }
        __syncthreads();
        *(f32x2*)(qj + v * 64 + kb) = c;
        Ss[vl * 65 + kb] = c[0]; Ss[vl * 65 + kb + 1] = c[1];
    }
    __threadfence();
    __syncthreads();
    if (tid == 0) __hip_atomic_fetch_add((int*)(a.ws + OFF_FLAG) + chain, 1, __ATOMIC_RELEASE, __HIP_MEMORY_SCOPE_AGENT);
    __syncthreads();
}
__device__ void rwkv_out_slice(const Args& a, int row0, int h);
struct CoopJob { int row0, S, h, dir, i0; const float* startp; };
__device__ void scan_coop(const Args& a, LAS unsigned char* lds, const CoopJob jA, const CoopJob jB, int n) {
    const bf16_t* PR = (const bf16_t*)(a.ws + OFF_PR); const bf16_t* LORA = (const bf16_t*)(a.ws + OFF_LORA);
    bf16_t* Y = (bf16_t*)(a.ws + OFF_Y); float* CB = (float*)(a.ws + OFF_C);
    const int wave = __builtin_amdgcn_readfirstlane(threadIdx.x >> 6), lane = threadIdx.x & 63, c = wave >> 2, rg = wave & 3, qd = lane >> 2, kq = lane & 3;
    const int row0 = c ? jB.row0 : jA.row0, S = c ? jB.S : jA.S, h = c ? jB.h : jA.h, dir = c ? jB.dir : jA.dir, i0 = c ? jB.i0 : jA.i0;
    const float* startp = c ? jB.startp : jA.startp;
    LAS float* buf = (LAS float*)lds + c * (2 * 8 * 384);
    const int ch = h * 64 + lane;
    const float mpr_r = a.in[I_MUP][ch], mnx_r = a.in[I_MUN][ch], mpr_k = a.in[I_MUP][512 + ch], mnx_k = a.in[I_MUN][512 + ch], mpr_v = a.in[I_MUP][1024 + ch], mnx_v = a.in[I_MUN][1024 + ch];
    const float kkc = a.in[I_KK][ch], kac = a.in[I_KA][ch], rkc = a.in[I_RK][ch];
    const float w0c = a.in[I_W0][dir * 512 + ch], a0c = a.in[I_A0][dir * 512 + ch];
    const int myrow = 16 * rg + qd;
    f32x2 St[8];
#pragma unroll
    for (int k2 = 0; k2 < 8; ++k2) St[k2] = startp ? *(const f32x2*)(startp + myrow * 64 + kq * 16 + 2 * k2) : (f32x2){0.f, 0.f};
    const int sd = dir ? -1 : 1, t0 = dir ? S - 1 - i0 : i0;
    bf16_t lr[2][3], lk[2][3], lv[2][3], lw[2], la[2];
    const bf16_t* prp = PR + (size_t)(row0 + t0 + sd * rg) * 1920 + ch;
    const bf16_t* lop = LORA + (size_t)(row0 + t0 + sd * rg) * 2048 + dir * 512 + ch;
    float* cbp = CB + ((size_t)dir * NTOK + row0 + t0 + sd * rg) * 8 + h;
    bf16_t* ypw = Y + ((size_t)dir * NTOK + row0 + t0) * 512 + h * 64 + myrow;
    const long rstep = (long)sd * 1920, lstep = (long)sd * 2048;
#define COOP_LOADS(IB, R_, K_, V_, W_, A_) _Pragma("unroll") for (int e = 0; e < 2; ++e) { const int t = t0 + sd * ((IB) + 4 * e + rg); const bool okp = t > 0, okn = t < S - 1; \
        const bf16_t* p = prp + rstep * ((IB) + 4 * e); \
        R_[e][1] = p[0]; K_[e][1] = p[512]; V_[e][1] = p[1024]; \
        const bf16_t r0_ = p[-1920], k0_ = p[-1920 + 512], v0_ = p[-1920 + 1024], r2_ = p[1920], k2_ = p[1920 + 512], v2_ = p[1920 + 1024]; \
        R_[e][0] = okp ? r0_ : (bf16_t)0; K_[e][0] = okp ? k0_ : (bf16_t)0; V_[e][0] = okp ? v0_ : (bf16_t)0; \
        R_[e][2] = okn ? r2_ : (bf16_t)0; K_[e][2] = okn ? k2_ : (bf16_t)0; V_[e][2] = okn ? v2_ : (bf16_t)0; \
        const bf16_t* lp = lop + lstep * ((IB) + 4 * e); W_[e] = lp[0]; A_[e] = lp[1024]; }
    COOP_LOADS(0, lr, lk, lv, lw, la)
    for (int ib = 0; ib < n; ib += 8) {
        bf16_t nr[2][3], nk[2][3], nv[2][3], nw[2], na[2];
        { const int ibn = (ib + 8 < n) ? ib + 8 : ib; COOP_LOADS(ibn, nr, nk, nv, nw, na) }
        LAS float* bb = buf + ((ib >> 3) & 1) * (8 * 384);
#pragma unroll
        for (int e = 0; e < 2; ++e) {
            const int t = t0 + sd * (ib + 4 * e + rg);
            const float rc = bf2f(lr[e][1]), kc = bf2f(lk[e][1]), vc = bf2f(lv[e][1]);
            const float r = rc + mpr_r * (bf2f(lr[e][0]) - rc) + mnx_r * (bf2f(lr[e][2]) - rc);
            const float k = kc + mpr_k * (bf2f(lk[e][0]) - kc) + mnx_k * (bf2f(lk[e][2]) - kc);
            const float v = vc + mpr_v * (bf2f(lv[e][0]) - vc) + mnx_v * (bf2f(lv[e][2]) - vc);
            const float wraw = bf2f(lw[e]) + w0c, apre = bf2f(la[e]) + a0c;
            const float w = __expf(-0.60653066f * __builtin_amdgcn_rcpf(1.f + __expf(-wraw)));
            const float av = __builtin_amdgcn_rcpf(1.f + __expf(-apre));
            const float kkr = k * kkc; const float ssq = wave_sum(kkr * kkr);
            const float kk = kkr * rsqrtf(fmaxf(ssq, 1e-24f));
            const float kd = k * (1.f + (av - 1.f) * kac);
            const float bq = kk * av;
            const float cd = wave_sum(r * kd * rkc);
            LAS float* o = bb + (4 * e + rg) * 384;
            o[lane] = w; o[64 + lane] = kk; o[128 + lane] = bq; o[192 + lane] = kd; o[256 + lane] = r; o[320 + lane] = v;
            cbp[(long)sd * 8 * (ib + 4 * e)] = cd;
        }
        asm volatile("s_waitcnt lgkmcnt(0)" ::: "memory");
        __builtin_amdgcn_s_barrier();
        asm volatile("" ::: "memory");
        f32x4 vb_[2][20]; float vr_[2];
#define ROW_LOAD(U) { const LAS f32x4* V4 = (const LAS f32x4*)(bb + (U) * 384); \
            _Pragma("unroll") for (int j = 0; j < 4; ++j) { vb_[(U) & 1][j] = V4[16 + kq * 4 + j]; vb_[(U) & 1][4 + j] = V4[kq * 4 + j]; vb_[(U) & 1][8 + j] = V4[32 + kq * 4 + j]; \
                vb_[(U) & 1][12 + j] = V4[48 + kq * 4 + j]; vb_[(U) & 1][16 + j] = V4[64 + kq * 4 + j]; } \
            vr_[(U) & 1] = bb[(U) * 384 + 320 + myrow]; }
        ROW_LOAD(0)
#pragma unroll
        for (int u = 0; u < 8; ++u) {
            if (u < 7) ROW_LOAD(u + 1)
            __builtin_amdgcn_sched_barrier(0);
            const f32x4* cv = vb_[u & 1];
            const float vr = vr_[u & 1];
            const f32x2 vv2 = (f32x2){vr, vr};
            f32x2 a0 = St[0] * (f32x2){cv[0][0], cv[0][1]}, a1 = St[1] * (f32x2){cv[0][2], cv[0][3]};
            f32x2 a2 = St[2] * (f32x2){cv[1][0], cv[1][1]}, a3 = St[3] * (f32x2){cv[1][2], cv[1][3]};
            a0 += St[4] * (f32x2){cv[2][0], cv[2][1]}; a1 += St[5] * (f32x2){cv[2][2], cv[2][3]};
            a2 += St[6] * (f32x2){cv[3][0], cv[3][1]}; a3 += St[7] * (f32x2){cv[3][2], cv[3][3]};
            f32x2 P[8];
#pragma unroll
            for (int j = 0; j < 4; ++j) { const f32x4 w4 = cv[4 + j], d4 = cv[12 + j];
                P[2 * j] = St[2 * j] * (f32x2){w4[0], w4[1]} + vv2 * (f32x2){d4[0], d4[1]};
                P[2 * j + 1] = St[2 * j + 1] * (f32x2){w4[2], w4[3]} + vv2 * (f32x2){d4[2], d4[3]}; }
            const f32x2 as_ = (a0 + a1) + (a2 + a3);
            const float sa = quad_sum(as_[0] + as_[1]);
            const f32x2 nsa = (f32x2){-sa, -sa};
#pragma unroll
            for (int j = 0; j < 4; ++j) { const f32x4 b4 = cv[8 + j];
                St[2 * j] = nsa * (f32x2){b4[0], b4[1]} + P[2 * j]; St[2 * j + 1] = nsa * (f32x2){b4[2], b4[3]} + P[2 * j + 1]; }
            f32x2 y0 = St[0] * (f32x2){cv[16][0], cv[16][1]}, y1 = St[1] * (f32x2){cv[16][2], cv[16][3]};
            f32x2 y2 = St[2] * (f32x2){cv[17][0], cv[17][1]}, y3 = St[3] * (f32x2){cv[17][2], cv[17][3]};
            y0 += St[4] * (f32x2){cv[18][0], cv[18][1]}; y1 += St[5] * (f32x2){cv[18][2], cv[18][3]};
            y2 += St[6] * (f32x2){cv[19][0], cv[19][1]}; y3 += St[7] * (f32x2){cv[19][2], cv[19][3]};
            const f32x2 ys_ = (y0 + y1) + (y2 + y3);
            const float y = quad_sum(ys_[0] + ys_[1]);
            ypw[(long)sd * 512 * (ib + u)] = (bf16_t)cvt_pk_bf16(y, y);
        }
#undef ROW_LOAD
#pragma unroll
        for (int e = 0; e < 2; ++e) {
#pragma unroll
            for (int q = 0; q < 3; ++q) { lr[e][q] = nr[e][q]; lk[e][q] = nk[e][q]; lv[e][q] = nv[e][q]; }
            lw[e] = nw[e]; la[e] = na[e]; }
    }
#undef COOP_LOADS
    __syncthreads();
}
__device__ void phase_scan_main(const Args& a, LAS unsigned char* lds, bool comb) {
    if (comb) for (int cj = blockIdx.x; cj < 64; cj += gridDim.x) combine_chain(a, lds, cj >> 2, cj & 3);
    for (int j = blockIdx.x; j < 256; j += gridDim.x) { const int sq = j >> 3, h = j & 7;
        CoopJob A; A.row0 = NP + sq * SS; A.S = SS; A.h = h; A.dir = 0; A.i0 = 0; A.startp = nullptr; CoopJob B = A; B.dir = 1;
        scan_coop(a, lds, A, B, SS);
        __threadfence(); __syncthreads();
        rwkv_out_slice(a, A.row0, h); }
    for (int pj = blockIdx.x; pj < 8 * NSEGP; pj += gridDim.x) { const int id = 2 * pj, chain = id / NSEGP, seg = id % NSEGP;
        const int* fl = (const int*)(a.ws + OFF_FLAG) + chain;
        while (__hip_atomic_load(fl, __ATOMIC_ACQUIRE, __HIP_MEMORY_SCOPE_AGENT) < 4) __builtin_amdgcn_s_sleep(8);
        CoopJob A; A.row0 = 0; A.S = NP; A.h = chain >> 1; A.dir = chain & 1; A.i0 = seg * SEG; A.startp = seg ? sum_slot(a, chain, seg - 1, 1) : nullptr;
        CoopJob B = A; B.i0 = (seg + 1) * SEG; B.startp = sum_slot(a, chain, seg, 1);
        scan_coop(a, lds, A, B, SEG); }
}

struct RwkvOutConst { float mp[8], mn[8], lw[8], lb[8]; };
__device__ __forceinline__ void rwkv_out_load_const(const Args& a, int ch, RwkvOutConst& c) {
#pragma unroll
    for (int j = 0; j < 8; ++j) { c.mp[j] = a.in[I_MUP][1024 + ch + j]; c.mn[j] = a.in[I_MUN][1024 + ch + j]; c.lw[j] = a.in[I_LNW][ch + j]; c.lb[j] = a.in[I_LNB][ch + j]; }
}
__device__ __forceinline__ void rwkv_out_item(const Args& a, int row, int ch, int h, const RwkvOutConst& c) {
    const bf16_t* PR = (const bf16_t*)(a.ws + OFF_PR); const bf16_t* Y = (const bf16_t*)(a.ws + OFF_Y); const float* CB = (const float*)(a.ws + OFF_C);
    const bf16_t* G = (const bf16_t*)((const unsigned char*)a.out + OUT_OFF_G); bf16_t* MIX = (bf16_t*)(a.ws + OFF_H);
    int pos, S; if (row < NP) { pos = row; S = NP; } else { pos = (row - NP) % SS; S = SS; }
    const bool hp = pos > 0, hn = pos < S - 1;
    const u32x4 yf = *(const u32x4*)(Y + (size_t)row * 512 + ch), yb = *(const u32x4*)(Y + ((size_t)NTOK + row) * 512 + ch);
    const u32x4 gg = *(const u32x4*)(G + (size_t)row * 512 + ch);
    const bf16_t* vp = PR + (size_t)row * 1920 + 1024 + ch;
    const u32x4 vc = *(const u32x4*)vp;
    const u32x4 vpv = hp ? *(const u32x4*)(vp - 1920) : (u32x4){0u, 0u, 0u, 0u};
    const u32x4 vnx = hn ? *(const u32x4*)(vp + 1920) : (u32x4){0u, 0u, 0u, 0u};
    const float cs = CB[(size_t)row * 8 + h] + CB[((size_t)NTOK + row) * 8 + h];
    float y[8], gv[8], vs[8];
#pragma unroll
    for (int j = 0; j < 4; ++j) {
        y[2 * j] = lo_bf(yf[j]) + lo_bf(yb[j]); y[2 * j + 1] = hi_bf(yf[j]) + hi_bf(yb[j]);
        gv[2 * j] = lo_bf(gg[j]); gv[2 * j + 1] = hi_bf(gg[j]);
        const float c0 = lo_bf(vc[j]), c1 = hi_bf(vc[j]);
        vs[2 * j] = c0 + c.mp[2 * j] * (lo_bf(vpv[j]) - c0) + c.mn[2 * j] * (lo_bf(vnx[j]) - c0);
        vs[2 * j + 1] = c1 + c.mp[2 * j + 1] * (hi_bf(vpv[j]) - c1) + c.mn[2 * j + 1] * (hi_bf(vnx[j]) - c1);
    }
    float s = 0.f;
#pragma unroll
    for (int j = 0; j < 8; ++j) s += y[j];
    s += __shfl_xor(s, 1); s += __shfl_xor(s, 2); s += __shfl_xor(s, 4);
    const float mu = s * (1.f / 64.f);
    float q = 0.f;
#pragma unroll
    for (int j = 0; j < 8; ++j) { const float dlt = y[j] - mu; q += dlt * dlt; }
    q += __shfl_xor(q, 1); q += __shfl_xor(q, 2); q += __shfl_xor(q, 4);
    const float rs = rsqrtf(q * (1.f / 64.f) + LNX_EPS);
    float o[8];
#pragma unroll
    for (int j = 0; j < 8; ++j) o[j] = ((y[j] - mu) * rs * c.lw[j] + c.lb[j] + cs * vs[j]) * gv[j];
    u32x4 w; w.x = cvt_pk_bf16(o[0], o[1]); w.y = cvt_pk_bf16(o[2], o[3]); w.z = cvt_pk_bf16(o[4], o[5]); w.w = cvt_pk_bf16(o[6], o[7]);
    *(u32x4*)(MIX + (size_t)row * DM + 512 + ch) = w;
}
__device__ void phase_rwkv_out(const Args& a) {
    const int wave = threadIdx.x >> 6, lane = threadIdx.x & 63, ch = lane * 8, h = lane >> 3;
    RwkvOutConst c; rwkv_out_load_const(a, ch, c);
    for (int row = blockIdx.x * 8 + wave; row < NP; row += gridDim.x * 8) rwkv_out_item(a, row, ch, h, c);
}
__device__ void rwkv_out_slice(const Args& a, int row0, int h) {
    const int wave = threadIdx.x >> 6, lane = threadIdx.x & 63, ch = h * 64 + (lane & 7) * 8;
    RwkvOutConst c; rwkv_out_load_const(a, ch, c);
    for (int r = wave * 8 + (lane >> 3); r < SS; r += 64) rwkv_out_item(a, row0 + r, ch, h, c);
}

#define XB_TMO      128
#define XB_XCNT(j)  (256  + 64 * (j))
#define XB_XSUB(j)  (1280 + 64 * (j))
#define XB_XGEN(j)  (2304 + 64 * (j))
#define XB_TOP      3328
#define XB_TOPGEN   3392
#define XCD_BAR_WORDS 3456
#define XB_SPIN_CAP (1u << 18)
__device__ __forceinline__ unsigned xb_ld(unsigned* p)              { return __hip_atomic_load(p, __ATOMIC_RELAXED, __HIP_MEMORY_SCOPE_AGENT); }
__device__ __forceinline__ unsigned xb_add(unsigned* p, unsigned v) { return __hip_atomic_fetch_add(p, v, __ATOMIC_RELAXED, __HIP_MEMORY_SCOPE_AGENT); }
__device__ __forceinline__ unsigned xb_xcc_id() { return (unsigned)__builtin_amdgcn_s_getreg((3 << 11) | 20) & 0xFu; }
#define XB_SPIN(cond, bar) do { unsigned _sp = 0; while (cond) { __builtin_amdgcn_s_sleep(1); \
    if ((++_sp & 255u) == 0u) { if (xb_ld(&(bar)[XB_TMO])) break; if (_sp > XB_SPIN_CAP) { atomicAdd(&(bar)[XB_TMO], 1u); break; } } } } while (0)
struct XcdBarrier { unsigned* bar; unsigned x; volatile LAS unsigned* st; };
__device__ __forceinline__ XcdBarrier xcd_barrier_post(unsigned* bar, volatile LAS unsigned* st) {
    XcdBarrier b; b.bar = bar; b.x = xb_xcc_id(); b.st = st;
    if (threadIdx.x == 0) (void)xb_add(&bar[XB_XCNT(b.x)], 1u);
    return b;
}
__device__ __forceinline__ void xcd_barrier_complete(unsigned* bar, unsigned x, unsigned& nloc, unsigned& nx) {
    const unsigned G = gridDim.x * gridDim.y * gridDim.z;
    unsigned sum, cnt, mine, sp = 0u;
    for (;;) {
        sum = 0u; cnt = 0u; mine = 0u;
#pragma unroll
        for (unsigned j = 0; j < 16; ++j) { const unsigned c = xb_ld(&bar[XB_XCNT(j)]); sum += c; cnt += (c > 0u) ? 1u : 0u; mine = (j == x) ? c : mine; }
        if (sum == G) break;
        __builtin_amdgcn_s_sleep(1);
        if ((++sp & 255u) == 0u) { if (xb_ld(&bar[XB_TMO])) break; if (sp > XB_SPIN_CAP) { atomicAdd(&bar[XB_TMO], 1u); break; } }
    }
    nloc = mine > 0u ? mine : 1u; nx = cnt > 0u ? cnt : 1u;
}
__device__ __forceinline__ void xcd_barrier(const XcdBarrier& b) {
    asm volatile("s_waitcnt vmcnt(0)" ::: "memory");
    __syncthreads();
    if (threadIdx.x == 0) {
        unsigned* bar = b.bar;
        __builtin_amdgcn_s_waitcnt(0);
        unsigned nloc = b.st[0], nx = b.st[1];
        if (nloc == 0u) { xcd_barrier_complete(bar, b.x, nloc, nx); b.st[0] = nloc; b.st[1] = nx; }
        const unsigned old = xb_add(&bar[XB_XSUB(b.x)], 1u);
        const unsigned gen = old / nloc;
        if (old + 1u == (gen + 1u) * nloc) {
            __builtin_amdgcn_fence(__ATOMIC_RELEASE, "agent");
            asm volatile("s_waitcnt vmcnt(0)" ::: "memory");
            const unsigned og = xb_add(&bar[XB_TOP], 1u);
            const unsigned tg = og / nx;
            if (og + 1u == (tg + 1u) * nx) xb_add(&bar[XB_TOPGEN], 1u);
            else XB_SPIN(xb_ld(&bar[XB_TOPGEN]) == tg, bar);
            __builtin_amdgcn_fence(__ATOMIC_ACQUIRE, "agent");
            xb_add(&bar[XB_XGEN(b.x)], 1u);
            asm volatile("s_waitcnt vmcnt(0)" ::: "memory");
        } else {
            XB_SPIN(xb_ld(&bar[XB_XGEN(b.x)]) == gen, bar);
            __builtin_amdgcn_fence(__ATOMIC_ACQUIRE, "agent");
            asm volatile("s_waitcnt vmcnt(0)" ::: "memory");
        }
    }
    __syncthreads();
}

template <class Epi>
__device__ __forceinline__ void run_gemm(LAS unsigned char* lds, const bf16_t* A, const bf16_t* Bt, int N, int K, const Epi& E) {
    pg8::Gemm g; g.A = A; g.Bt = Bt; g.M = NTOK; g.N = N; g.K = K;
    pg8::StaticOrder S; S.init(NTOK, N, (int)gridDim.x, (int)blockIdx.x);
    pg8::gemm_phase<Epi>(lds, g, S, E);
}

__global__ void __launch_bounds__(512, 2) mega(Args a) {
    extern __shared__ __attribute__((aligned(16))) unsigned char shm[];
    LAS unsigned char* lds = (LAS unsigned char*)shm;
    cg::grid_group grid = cg::this_grid();
    volatile LAS unsigned* xst = (volatile LAS unsigned*)(lds + 131072);
    if (threadIdx.x == 0) { xst[0] = 0u; xst[1] = 0u; }
    __syncthreads();
    const XcdBarrier xb = xcd_barrier_post((unsigned*)(a.ws + OFF_BAR), xst);
#ifndef PHMASK
#define PHMASK 0xFFF
#endif
#ifndef DUP
#define DUP 0
#endif
#define PHASE(k, body) if (a.ph_lo <= (k) && (k) < a.ph_hi) { if ((k) != a.ph_lo) { if ((k) == 1) grid.sync(); else xcd_barrier(xb); } if constexpr ((PHMASK >> (k)) & 1) { body } }
    PHASE(0, phase_prep_weights(a, lds); phase_mod(a, lds); if (DUP & 8) { phase_prep_weights(a, lds); phase_mod(a, lds); })
    PHASE(1, phase_norm(a, a.in[I_XP], a.in[I_XS], a.in[I_G1], 0, 1024); if (DUP & 32) phase_norm(a, a.in[I_XP], a.in[I_XS], a.in[I_G1], 0, 1024);)
    PHASE(2, EpiIn E; E.QKV = (bf16_t*)a.out; E.PR = (bf16_t*)(a.ws + OFF_PR); E.qg = a.in[I_QG]; E.kg = a.in[I_KG];
             run_gemm(lds, (const bf16_t*)(a.ws + OFF_H), (const bf16_t*)(a.ws + OFF_WIN), NINP, 1024, E); if (DUP & 16) run_gemm(lds, (const bf16_t*)(a.ws + OFF_H), (const bf16_t*)(a.ws + OFF_WIN), NINP, 1024, E);)
    PHASE(3, phase_post_in(a); if (DUP & 64) { for (int q = 0; q < 10; ++q) grid.sync(); })
    PHASE(4, EpiLora E; E.LORA = (bf16_t*)(a.ws + OFF_LORA); E.G = (bf16_t*)((unsigned char*)a.out + OUT_OFF_G); E.w0 = a.in[I_W0]; E.a0 = a.in[I_A0];
             run_gemm(lds, (const bf16_t*)(a.ws + OFF_X5), (const bf16_t*)(a.ws + OFF_WL), 2560, 384, E);)
    PHASE(5, phase_attn(a, lds); if (DUP & 1) phase_attn(a, lds); phase_scan_pass1(a, lds); if (DUP & 4) phase_scan_pass1(a, lds);)
    PHASE(6, phase_scan_main(a, lds, true); if (DUP & 2) phase_scan_main(a, lds, false);)
    PHASE(7, phase_rwkv_out(a); if (DUP & 32) phase_rwkv_out(a);)
    PHASE(8, EpiRes E; E.out = a.out; E.xp = a.in[I_XP]; E.xs = a.in[I_XS]; E.mod = (const float*)(a.ws + OFF_MOD); E.gate_off = 2048;
             run_gemm(lds, (const bf16_t*)(a.ws + OFF_H), (const bf16_t*)(a.ws + OFF_WOUT), 1024, 1024, E);)
    PHASE(9, phase_norm(a, a.out, a.out + (size_t)NP * DM, a.in[I_G2], 3072, 4096);)
    PHASE(10, EpiFf1 E; E.HID = (bf16_t*)(a.ws + OFF_HID);
             run_gemm(lds, (const bf16_t*)(a.ws + OFF_H), (const bf16_t*)(a.ws + OFF_WFF1), DFF, 1024, E); if (DUP & 16) run_gemm(lds, (const bf16_t*)(a.ws + OFF_H), (const bf16_t*)(a.ws + OFF_WFF1), DFF, 1024, E);)
    PHASE(11, EpiRes E; E.out = a.out; E.xp = nullptr; E.xs = nullptr; E.mod = (const float*)(a.ws + OFF_MOD); E.gate_off = 5120;
             run_gemm(lds, (const bf16_t*)(a.ws + OFF_HID), (const bf16_t*)(a.ws + OFF_WFF2), 1024, DFF, E);)
}

#ifndef N_LAUNCHES
#define N_LAUNCHES 1
#endif

extern "C" void kernel_launch(void* const* d_in, const int* in_sizes, int n_in, void* d_out, int out_size, void* d_ws, size_t ws_size, hipStream_t stream) {
    static int grid = 0;
    if (grid == 0) {
        if (n_in != 27 || out_size != NTOK * DM || ws_size < WS_END) { fprintf(stderr, "kernel_launch: unexpected shapes (n_in %d out %d ws %zu need %zu)\n", n_in, out_size, ws_size, (size_t)WS_END); grid = -1; return; }
        int dev = 0, cus = 0, per_cu = 0;
        hipGetDevice(&dev);
        hipDeviceGetAttribute(&cus, hipDeviceAttributeMultiprocessorCount, dev);
        hipFuncSetAttribute((const void*)mega, hipFuncAttributeMaxDynamicSharedMemorySize, LDS_BYTES);
        hipOccupancyMaxActiveBlocksPerMultiprocessor(&per_cu, (const void*)mega, 512, LDS_BYTES);
        if (per_cu < 1) { fprintf(stderr, "kernel_launch: occupancy query says %d blocks/CU\n", per_cu); per_cu = 1; }
        grid = cus * per_cu;
        (void)hipGetLastError();
    }
    if (grid < 0) return;
    if (hipMemsetAsync((char*)d_ws + OFF_BAR, 0, BAR_BYTES, stream) != hipSuccess) { fprintf(stderr, "kernel_launch: memset of the barrier words failed\n"); return; }
    Args a{};
    for (int i = 0; i < 27; ++i) a.in[i] = (const float*)d_in[i];
    a.out = (float*)d_out; a.ws = (unsigned char*)d_ws;
    if (N_LAUNCHES == 1) {
        a.ph_lo = 0; a.ph_hi = NPH;
        void* args[] = {&a};
        hipError_t e = hipLaunchCooperativeKernel((const void*)mega, dim3(grid), dim3(512), args, LDS_BYTES, stream);
        if (e != hipSuccess) fprintf(stderr, "cooperative launch failed: %s (grid %d)\n", hipGetErrorString(e), grid);
    } else {
        for (int ph = 0; ph < NPH; ++ph) {
            a.ph_lo = ph; a.ph_hi = ph + 1;
            void* args[] = {&a};
            hipError_t e = hipLaunchCooperativeKernel((const void*)mega, dim3(grid), dim3(512), args, LDS_BYTES, stream);
            if (e != hipSuccess) fprintf(stderr, "cooperative launch failed: %s (grid %d)\n", hipGetErrorString(e), grid);
        }
    }
}
```

```cpp
#include <hip/hip_runtime.h>
#include <hip/hip_cooperative_groups.h>
#include <cstdio>
namespace cg = cooperative_groups;

#define LAS __attribute__((address_space(3)))
typedef unsigned short bf16_t;
typedef short bf16x8 __attribute__((ext_vector_type(8)));
typedef float f32x4 __attribute__((ext_vector_type(4)));
typedef float f32x2 __attribute__((ext_vector_type(2)));
typedef unsigned u32x4 __attribute__((ext_vector_type(4)));
typedef unsigned u32x2 __attribute__((ext_vector_type(2)));

constexpr int NTOK = 81920, NP = 16384, SS = 2048, DM = 1024, NSEQ = 33;
constexpr int NIN = 3456, NINP = 3584, DFF = 4096;
constexpr float NORM_EPS = 1e-6f, LNX_EPS = 64e-5f;
constexpr int LDS_BYTES = 131072 + 16;
constexpr int NPH = 12;

constexpr size_t OFF_WIN = 0;
constexpr size_t OFF_WOUT = OFF_WIN + (size_t)NINP * 1024 * 2;
constexpr size_t OFF_WFF1 = OFF_WOUT + (size_t)1024 * 1024 * 2;
constexpr size_t OFF_WFF2 = OFF_WFF1 + (size_t)4096 * 1024 * 2;
constexpr size_t OFF_WL = OFF_WFF2 + (size_t)1024 * 4096 * 2;
constexpr size_t OFF_MOD = OFF_WL + (size_t)2560 * 384 * 2;
constexpr size_t OFF_C = OFF_MOD + (size_t)NSEQ * 6144 * 4;
constexpr size_t OFF_H = OFF_C + (size_t)2 * NTOK * 8 * 4;
constexpr size_t OFF_PR = OFF_H + (size_t)NTOK * 1024 * 2;
constexpr size_t OFF_LORA = OFF_PR + (size_t)NTOK * 1920 * 2;
constexpr size_t OFF_Y = OFF_LORA + (size_t)NTOK * 2048 * 2;
constexpr size_t OFF_SUM = OFF_Y + (size_t)NTOK * 1024 * 2;
constexpr size_t OFF_FLAG = OFF_SUM + (size_t)16 * 64 * 32768;
constexpr size_t OFF_BAR = OFF_FLAG + 256;
constexpr size_t BAR_BYTES = 3456 * 4;
constexpr size_t WS_END = OFF_BAR + 16384;
constexpr size_t OFF_X5 = OFF_Y;
constexpr size_t OFF_HID = OFF_PR;
static_assert(OFF_HID + (size_t)NTOK * 4096 * 2 <= WS_END, "hid fits");
constexpr size_t OUT_OFF_G = (size_t)NTOK * 1536 * 2;

struct Args {
    const float* in[27];
    float* out;
    unsigned char* ws;
    int ph_lo, ph_hi;
};
enum { I_XP = 0, I_XS, I_CP, I_CS, I_WADA, I_BADA, I_G1, I_G2, I_WIN, I_QG, I_KG, I_BETA, I_MUP, I_MUN, I_W0, I_WUP, I_A0, I_AUP, I_GUP, I_KK, I_KA, I_RK, I_LNW, I_LNB, I_WOUT, I_WFF1, I_WFF2 };

__device__ __forceinline__ float bf2f(bf16_t b) { return __uint_as_float(((unsigned)b) << 16); }
__device__ __forceinline__ bf16_t f2bf(float f) { unsigned u = __float_as_uint(f); u += 0x7FFFu + ((u >> 16) & 1u); return (bf16_t)(u >> 16); }
__device__ __forceinline__ unsigned cvt_pk_bf16(float lo, float hi) { unsigned r; asm volatile("v_cvt_pk_bf16_f32 %0, %1, %2" : "=v"(r) : "v"(lo), "v"(hi)); return r; }
__device__ __forceinline__ float lo_bf(unsigned u) { return __uint_as_float(u << 16); }
__device__ __forceinline__ float hi_bf(unsigned u) { return __uint_as_float(u & 0xffff0000u); }
template <int CTRL> __device__ __forceinline__ float dpp_mov(float x) { return __int_as_float(__builtin_amdgcn_update_dpp(0, __float_as_int(x), CTRL, 0xF, 0xF, true)); }
__device__ __forceinline__ float wave_sum(float v) {
    v += dpp_mov<0xB1>(v); v += dpp_mov<0x4E>(v); v += dpp_mov<0x141>(v); v += dpp_mov<0x140>(v);
    const float s0 = __int_as_float(__builtin_amdgcn_readlane(__float_as_int(v), 0)), s1 = __int_as_float(__builtin_amdgcn_readlane(__float_as_int(v), 16));
    const float s2 = __int_as_float(__builtin_amdgcn_readlane(__float_as_int(v), 32)), s3 = __int_as_float(__builtin_amdgcn_readlane(__float_as_int(v), 48));
    return (s0 + s1) + (s2 + s3);
}
__device__ __forceinline__ float wave_max(float v) {
#pragma unroll
    for (int o = 32; o >= 1; o >>= 1) v = fmaxf(v, __shfl_xor(v, o));
    return v;
}
__device__ __forceinline__ int seq_of_row(int row) { return row < NP ? 0 : 1 + (row - NP) / SS; }

namespace pg8 {
constexpr int BM = 256, BK = 64, HALF = 128, HTB = HALF * BK * 2, STAGE_BYTES = 8 * HTB, NXCD = 8, WGM = 8;
__device__ __forceinline__ int lds_byte(int r, int c) { const int st = (r >> 4) * 2 + (c >> 5), rr = r & 15, cc = c & 31, ob = rr * 64 + cc * 2; return st * 1024 + (ob ^ (((ob >> 9) & 1) << 5)); }
__device__ __forceinline__ void stage_rc(int b, int& R, int& C) { const int st = b / 1024, sb = b % 1024, swz = sb ^ (((sb >> 9) & 1) << 5); R = (st >> 1) * 16 + swz / 64; C = (st & 1) * 32 + (swz % 64) / 2; }
__device__ __forceinline__ int perm32(int rho) { const int n = rho >> 4, i = rho & 15; return 8 * (i >> 2) + 4 * n + (i & 3); }
struct Unit { int pm, pn; };
struct Gemm { const bf16_t* A; const bf16_t* Bt; int M, N, K; };
struct StaticOrder {
    int nM, nN, nwg, G, c;
    __device__ void init(int M, int N, int G_, int c_) { nM = M / BM; nN = N / BM; nwg = nM * nN; G = G_; c = c_; }
    __device__ bool next(int i, Unit& u) const {
        const long L = (long)i * G + c; if (L >= nwg) return false;
        int wgid = (int)L; { const int q = nwg / NXCD, r = nwg % NXCD, xcd = wgid % NXCD, off = wgid / NXCD; wgid = (xcd < r ? xcd * (q + 1) : r * (q + 1) + (xcd - r) * q) + off; }
        const int nig = WGM * nN, gid = wgid / nig, fm = gid * WGM, gsz = (nM - fm) < WGM ? (nM - fm) : WGM;
        u.pm = fm + ((wgid % nig) % gsz); u.pn = (wgid % nig) / gsz; return true;
    }
};

template <class Epi>
__device__ __forceinline__ void gemm_phase(LAS unsigned char* lds, const Gemm g, const StaticOrder& S, const Epi& E) {
    const int tid = threadIdx.x, wid = __builtin_amdgcn_readfirstlane(tid >> 6), lane = tid & 63, wr = wid >> 2, wc = wid & 3, fr = lane & 15, fq = lane >> 4;
    const int K = g.K, nt = K / BK;
    unsigned voffA[2], voffB[2];
#pragma unroll
    for (int i = 0; i < 2; ++i) { int R, C; stage_rc(tid * 16 + i * 8192, R, C); const int Rb = Epi::PERM ? ((R & ~31) + perm32(R & 31)) : R;
        const int Rh = 64 * (R >> 5) + perm32(R & 31);
        voffA[i] = (unsigned)(R * K + C) * 2u; voffB[i] = (unsigned)((Epi::HEADMAP ? Rh : Rb) * K + C) * 2u; }
    const size_t kstep = (size_t)(BK * 2);
    const size_t hstep = (size_t)HALF * K * 2;
    const size_t tstep = 2 * hstep;
    const size_t hstepB = Epi::HEADMAP ? (size_t)32 * K * 2 : hstep;
    const unsigned ldsw = (unsigned)wid * 1024u;
    const int aoff = lds_byte(wr * 64 + fr, fq * 8), boff = lds_byte(wc * 32 + fr, fq * 8);
#define PG8_SA(b, h) (((b) * 2 + (h)) * HTB)
#define PG8_SB(b, h) ((4 + (b) * 2 + (h)) * HTB)
#define PG8_STAGE(bufoff, gbase, voff) do { _Pragma("unroll") for (int _i = 0; _i < 2; ++_i) \
        __builtin_amdgcn_global_load_lds((const unsigned*)((const char*)(gbase) + (voff)[_i]), (LAS unsigned*)(lds + (bufoff) + ldsw + _i * 8192), 16, 0, 0); } while (0)
#define PG8_LDA(dst, b, h) do { _Pragma("unroll") for (int m = 0; m < 4; ++m) _Pragma("unroll") for (int k = 0; k < 2; ++k) dst[m][k] = *(const LAS bf16x8*)(lds + PG8_SA(b, h) + aoff + m * 2048 + k * 1024); } while (0)
#define PG8_LDB(dst, b, h) do { _Pragma("unroll") for (int n = 0; n < 2; ++n) _Pragma("unroll") for (int k = 0; k < 2; ++k) dst[n][k] = *(const LAS bf16x8*)(lds + PG8_SB(b, h) + boff + n * 2048 + k * 1024); } while (0)
#define PG8_MMA(ai, bj, At, Bt) do { __builtin_amdgcn_s_setprio(1); _Pragma("unroll") for (int m = 0; m < 4; ++m) _Pragma("unroll") for (int n = 0; n < 2; ++n) _Pragma("unroll") for (int k = 0; k < 2; ++k) \
        acc[ai][bj][m][n] = __builtin_amdgcn_mfma_f32_16x16x32_bf16(Bt[n][k], At[m][k], acc[ai][bj][m][n], 0, 0, 0); __builtin_amdgcn_s_setprio(0); } while (0)
#define PG8_WAIT_V(n) asm volatile("s_waitcnt vmcnt(" #n ")" ::: "memory")
#define PG8_WAIT_L(n) asm volatile("s_waitcnt lgkmcnt(" #n ")" ::: "memory")
#define PG8_BAR __builtin_amdgcn_s_barrier()
#define PG8_SCHED __builtin_amdgcn_sched_barrier(0)
    Unit cur, nxt; int ui = 0;
    if (!S.next(0, cur)) return;
    f32x4 acc[2][2][4][2];
#pragma unroll
    for (int a = 0; a < 2; ++a)
#pragma unroll
        for (int b = 0; b < 2; ++b)
#pragma unroll
            for (int m = 0; m < 4; ++m)
#pragma unroll
                for (int n = 0; n < 2; ++n) acc[a][b][m][n] = (f32x4){0.f, 0.f, 0.f, 0.f};
    bf16x8 At[4][2], B0[2][2], B1[2][2];
    const char* cA = (const char*)g.A + (size_t)cur.pm * tstep; const char* cB = (const char*)g.Bt + (size_t)cur.pn * tstep;
    PG8_STAGE(PG8_SB(0, 0), cB, voffB); PG8_STAGE(PG8_SA(0, 0), cA, voffA); PG8_STAGE(PG8_SB(0, 1), cB + hstepB, voffB); PG8_STAGE(PG8_SA(0, 1), cA + hstep, voffA);
    if (wr == 1) PG8_BAR;
    PG8_WAIT_V(4); PG8_BAR;
    PG8_STAGE(PG8_SB(1, 0), cB + kstep, voffB); PG8_STAGE(PG8_SA(1, 0), cA + kstep, voffA); PG8_STAGE(PG8_SB(1, 1), cB + hstepB + kstep, voffB);
    PG8_WAIT_V(6); PG8_BAR;
    for (;;) {
        const bool has_next = S.next(ui + 1, nxt);
        const char* nA = has_next ? (const char*)g.A + (size_t)nxt.pm * tstep : cA; const char* nB = has_next ? (const char*)g.Bt + (size_t)nxt.pn * tstep : cB;
#pragma unroll 1
        for (int t = 0; t < nt; t += 2) {
            const bool last = (t == nt - 2);
            const char* a1 = cA + (size_t)(t + 1) * kstep;
            const char* a2 = last ? nA : cA + (size_t)(t + 2) * kstep; const char* b2 = last ? nB : cB + (size_t)(t + 2) * kstep;
            const char* a3 = a2 + kstep; const char* b3 = b2 + kstep;
            PG8_LDB(B0, 0, 0); PG8_SCHED; PG8_LDA(At, 0, 0); PG8_STAGE(PG8_SA(1, 1), a1 + hstep, voffA);
            PG8_WAIT_L(8); PG8_BAR; PG8_WAIT_L(0); PG8_MMA(0, 0, At, B0); PG8_BAR; PG8_SCHED;
            PG8_LDB(B1, 0, 1); PG8_STAGE(PG8_SB(0, 0), b2, voffB);
            PG8_BAR; PG8_WAIT_L(0); PG8_MMA(0, 1, At, B1); PG8_BAR;
            PG8_LDA(At, 0, 1); PG8_STAGE(PG8_SA(0, 0), a2, voffA);
            PG8_BAR; PG8_WAIT_L(0); PG8_MMA(1, 0, At, B0); PG8_BAR; PG8_SCHED;
            PG8_STAGE(PG8_SB(0, 1), b2 + hstepB, voffB);
            PG8_WAIT_V(6); PG8_BAR; PG8_MMA(1, 1, At, B1); PG8_BAR;
            PG8_LDB(B0, 1, 0); PG8_SCHED; PG8_LDA(At, 1, 0); PG8_STAGE(PG8_SA(0, 1), a2 + hstep, voffA);
            PG8_WAIT_L(8); PG8_BAR; PG8_WAIT_L(0); PG8_MMA(0, 0, At, B0); PG8_BAR; PG8_SCHED;
            PG8_LDB(B1, 1, 1); PG8_STAGE(PG8_SB(1, 0), b3, voffB);
            PG8_BAR; PG8_WAIT_L(0); PG8_MMA(0, 1, At, B1); PG8_BAR;
            PG8_LDA(At, 1, 1); PG8_STAGE(PG8_SA(1, 0), a3, voffA);
            PG8_BAR; PG8_WAIT_L(0); PG8_MMA(1, 0, At, B0); PG8_BAR; PG8_SCHED;
            PG8_STAGE(PG8_SB(1, 1), b3 + hstepB, voffB);
            PG8_WAIT_V(6); PG8_BAR; PG8_MMA(1, 1, At, B1); PG8_BAR;
        }
        E(acc, cur, wr, wc, fr, fq);
        if (!has_next) break;
#pragma unroll
        for (int a = 0; a < 2; ++a)
#pragma unroll
            for (int b = 0; b < 2; ++b)
#pragma unroll
                for (int m = 0; m < 4; ++m)
#pragma unroll
                    for (int n = 0; n < 2; ++n) acc[a][b][m][n] = (f32x4){0.f, 0.f, 0.f, 0.f};
        cur = nxt; cA = nA; cB = nB; ++ui;
    }
    PG8_WAIT_V(0);
    if (wr == 0) PG8_BAR;
    PG8_BAR;
#undef PG8_SA
#undef PG8_SB
#undef PG8_STAGE
#undef PG8_LDA
#undef PG8_LDB
#undef PG8_MMA
#undef PG8_WAIT_V
#undef PG8_WAIT_L
#undef PG8_BAR
#undef PG8_SCHED
}
}
using pg8::Unit;
typedef f32x4 AccT[2][2][4][2];

struct EpiIn {
    static constexpr bool PERM = true, HEADMAP = true;
    bf16_t* QKV; bf16_t* PR; const float* qg; const float* kg;
    __device__ __forceinline__ void operator()(const AccT& acc, const Unit& u, int wr, int wc, int fr, int fq) const {
        const int row0 = u.pm * 256 + wr * 64 + fr;
        bf16_t* base; int ldc, colt, lim;
        if (u.pn < 6) { base = QKV; ldc = 1536; colt = u.pn * 256; lim = 1536; } else { base = PR; ldc = 1920; colt = (u.pn - 6) * 256; lim = 1920; }
        const int col0 = colt + wc * 64 + 8 * fq;
        const bool nrm = u.pn < 4;
        f32x4 g4[2][2];
        if (nrm) { const float* gp = (u.pn < 2 ? qg : kg) + 8 * fq;
#pragma unroll
            for (int bj = 0; bj < 2; ++bj)
#pragma unroll
                for (int n = 0; n < 2; ++n) g4[bj][n] = *(const f32x4*)(gp + 32 * bj + 4 * n); }
        const float qs = u.pn < 2 ? 0.125f : 1.f;
#pragma unroll
        for (int ai = 0; ai < 2; ++ai)
#pragma unroll
            for (int m = 0; m < 4; ++m) { bf16_t* rowp = base + (size_t)(row0 + ai * 128 + m * 16) * ldc + col0;
                f32x4 v[2][2];
#pragma unroll
                for (int bj = 0; bj < 2; ++bj)
#pragma unroll
                    for (int n = 0; n < 2; ++n) v[bj][n] = acc[ai][bj][m][n];
                if (nrm) {
                    float ss = 0.f;
#pragma unroll
                    for (int bj = 0; bj < 2; ++bj)
#pragma unroll
                        for (int n = 0; n < 2; ++n) ss += v[bj][n][0] * v[bj][n][0] + v[bj][n][1] * v[bj][n][1] + v[bj][n][2] * v[bj][n][2] + v[bj][n][3] * v[bj][n][3];
                    ss += __shfl_xor(ss, 16); ss += __shfl_xor(ss, 32);
                    const float sc = rsqrtf(ss * (1.f / 64.f) + NORM_EPS) * qs;
#pragma unroll
                    for (int bj = 0; bj < 2; ++bj)
#pragma unroll
                        for (int n = 0; n < 2; ++n) v[bj][n] = v[bj][n] * sc * g4[bj][n];
                }
#pragma unroll
                for (int bj = 0; bj < 2; ++bj) {
                    u32x4 w; w.x = cvt_pk_bf16(v[bj][0][0], v[bj][0][1]); w.y = cvt_pk_bf16(v[bj][0][2], v[bj][0][3]); w.z = cvt_pk_bf16(v[bj][1][0], v[bj][1][1]); w.w = cvt_pk_bf16(v[bj][1][2], v[bj][1][3]);
                    if (col0 + bj * 32 < lim) *(u32x4*)(rowp + bj * 32) = w; } }
    }
};
struct EpiLora {
    static constexpr bool PERM = true, HEADMAP = false;
    bf16_t* LORA; bf16_t* G; const float* w0; const float* a0;
    __device__ __forceinline__ void operator()(const AccT& acc, const Unit& u, int wr, int wc, int fr, int fq) const {
        const int row0 = u.pm * 256 + wr * 64 + fr;
        bf16_t* base; int ldc, colt; const bool isg = u.pn >= 8;
        if (!isg) { base = LORA; ldc = 2048; colt = u.pn * 256; } else { base = G; ldc = 512; colt = (u.pn - 8) * 256; }
        const int col0 = colt + wc * 32 + 8 * fq;
#pragma unroll
        for (int bj = 0; bj < 2; ++bj) {
#pragma unroll
            for (int ai = 0; ai < 2; ++ai)
#pragma unroll
                for (int m = 0; m < 4; ++m) { bf16_t* rowp = base + (size_t)(row0 + ai * 128 + m * 16) * ldc + col0 + bj * 128;
                    const f32x4 v0 = acc[ai][bj][m][0], v1 = acc[ai][bj][m][1];
                    u32x4 w; w.x = cvt_pk_bf16(v0[0], v0[1]); w.y = cvt_pk_bf16(v0[2], v0[3]); w.z = cvt_pk_bf16(v1[0], v1[1]); w.w = cvt_pk_bf16(v1[2], v1[3]);
                    *(u32x4*)rowp = w; }
        }
    }
};
struct EpiFf1 {
    static constexpr bool PERM = true, HEADMAP = false;
    bf16_t* HID;
    __device__ __forceinline__ void operator()(const AccT& acc, const Unit& u, int wr, int wc, int fr, int fq) const {
        const int row0 = u.pm * 256 + wr * 64 + fr;
        const int col0 = u.pn * 256 + wc * 32 + 8 * fq;
#pragma unroll
        for (int ai = 0; ai < 2; ++ai)
#pragma unroll
            for (int m = 0; m < 4; ++m) { bf16_t* rowp = HID + (size_t)(row0 + ai * 128 + m * 16) * DFF + col0;
#pragma unroll
                for (int bj = 0; bj < 2; ++bj) { f32x4 v0 = acc[ai][bj][m][0], v1 = acc[ai][bj][m][1];
#pragma unroll
                    for (int j = 0; j < 4; ++j) { const float a = fmaxf(v0[j], 0.f), b = fmaxf(v1[j], 0.f); v0[j] = a * a; v1[j] = b * b; }
                    u32x4 w; w.x = cvt_pk_bf16(v0[0], v0[1]); w.y = cvt_pk_bf16(v0[2], v0[3]); w.z = cvt_pk_bf16(v1[0], v1[1]); w.w = cvt_pk_bf16(v1[2], v1[3]);
                    *(u32x4*)(rowp + bj * 128) = w; } }
    }
};
struct EpiRes {
    static constexpr bool PERM = false, HEADMAP = false;
    float* out; const float* xp; const float* xs; const float* mod; int gate_off;
    __device__ __forceinline__ void operator()(const AccT& acc, const Unit& u, int wr, int wc, int fr, int fq) const {
        const int row0 = u.pm * 256 + wr * 64 + fr, col0 = u.pn * 256 + wc * 32 + 4 * fq;
        const int sq = seq_of_row(u.pm * 256);
        const float* gp = mod + (size_t)sq * 6144 + gate_off + col0;
        f32x4 gv[2][2];
#pragma unroll
        for (int bj = 0; bj < 2; ++bj)
#pragma unroll
            for (int n = 0; n < 2; ++n) gv[bj][n] = *(const f32x4*)(gp + bj * 128 + n * 16);
#pragma unroll
        for (int ai = 0; ai < 2; ++ai)
#pragma unroll
            for (int m = 0; m < 4; ++m) { const int row = row0 + ai * 128 + m * 16;
                float* op = out + (size_t)row * DM + col0;
                const float* rp = xp ? (row < NP ? xp + (size_t)row * DM : xs + (size_t)(row - NP) * DM) + col0 : op;
#pragma unroll
                for (int bj = 0; bj < 2; ++bj)
#pragma unroll
                    for (int n = 0; n < 2; ++n) { const f32x4 r = *(const f32x4*)(rp + bj * 128 + n * 16);
                        *(f32x4*)(op + bj * 128 + n * 16) = r + gv[bj][n] * acc[ai][bj][m][n]; } }
    }
};

__device__ void xpose_tile(LAS float* tile, const float* W, int N, int K, int k0, int n0, bf16_t* Wt) {
    const int tid = threadIdx.x;
#pragma unroll
    for (int i = 0; i < 8; ++i) { const int kk = (tid >> 6) + 8 * i, nn = tid & 63; tile[kk * 65 + nn] = W[(size_t)(k0 + kk) * N + n0 + nn]; }
    __syncthreads();
#pragma unroll
    for (int i = 0; i < 8; ++i) { const int nn = (tid >> 6) + 8 * i, kk = tid & 63; Wt[(size_t)(n0 + nn) * K + k0 + kk] = f2bf(tile[kk * 65 + nn]); }
    __syncthreads();
}
__device__ void phase_prep_weights(const Args& a, LAS unsigned char* lds) {
    LAS float* tile = (LAS float*)lds;
    bf16_t* WIN = (bf16_t*)(a.ws + OFF_WIN); bf16_t* WOUT = (bf16_t*)(a.ws + OFF_WOUT); bf16_t* WFF1 = (bf16_t*)(a.ws + OFF_WFF1); bf16_t* WFF2 = (bf16_t*)(a.ws + OFF_WFF2); bf16_t* WL = (bf16_t*)(a.ws + OFF_WL);
    for (int t = blockIdx.x; t < 3168; t += gridDim.x) {
        if (t < 864) { const int kt = t / 54, ntl = t % 54; xpose_tile(tile, a.in[I_WIN], NIN, 1024, kt * 64, ntl * 64, WIN); }
        else if (t < 1120) { const int u = t - 864; xpose_tile(tile, a.in[I_WOUT], 1024, 1024, (u / 16) * 64, (u % 16) * 64, WOUT); }
        else if (t < 2144) { const int u = t - 1120; xpose_tile(tile, a.in[I_WFF1], 4096, 1024, (u / 64) * 64, (u % 64) * 64, WFF1); }
        else { const int u = t - 2144; xpose_tile(tile, a.in[I_WFF2], 1024, 4096, (u / 16) * 64, (u % 16) * 64, WFF2); }
    }
    const int gtid = blockIdx.x * 512 + threadIdx.x, gn = gridDim.x * 512;
    if (gtid < 64) ((int*)(a.ws + OFF_FLAG))[gtid] = 0;
    for (int i = gtid; i < 128 * 1024; i += gn) WIN[(size_t)NIN * 1024 + i] = 0;
    for (int i = gtid; i < 2560 * 384; i += gn) {
        const int n = i / 384, kc = i % 384; float v = 0.f;
        if (n < 512) { if (kc < 64) v = a.in[I_WUP][(size_t)(0 * 64 + kc) * 512 + n]; }
        else if (n < 1024) { if (kc >= 64 && kc < 128) v = a.in[I_WUP][(size_t)(1 * 64 + kc - 64) * 512 + (n - 512)]; }
        else if (n < 1536) { if (kc >= 128 && kc < 192) v = a.in[I_AUP][(size_t)(0 * 64 + kc - 128) * 512 + (n - 1024)]; }
        else if (n < 2048) { if (kc >= 192 && kc < 256) v = a.in[I_AUP][(size_t)(1 * 64 + kc - 192) * 512 + (n - 1536)]; }
        else { if (kc >= 256) v = a.in[I_GUP][(size_t)(kc - 256) * 512 + (n - 2048)]; }
        WL[i] = f2bf(v);
    }
}
__device__ void phase_mod(const Args& a, LAS unsigned char* lds) {
    float* MOD = (float*)(a.ws + OFF_MOD);
    const int wave = threadIdx.x >> 6, lane = threadIdx.x & 63;
    LAS float* sl = (LAS float*)lds + wave * (64 * 36);
    for (int it = blockIdx.x; it < 96; it += gridDim.x) {
        const int j0 = it * 64;
        float acc[36];
#pragma unroll
        for (int b = 0; b < 36; ++b) acc[b] = 0.f;
        for (int half = 0; half < 2; ++half) {
            const int k0 = wave * 128 + half * 64;
#pragma unroll 1
            for (int b = 0; b < 36; ++b) { float sv = 0.f;
                if (b < NSEQ) { const float c = (b == 0) ? a.in[I_CP][k0 + lane] : a.in[I_CS][(size_t)(b - 1) * DM + k0 + lane]; sv = c / (1.f + __expf(-c)); }
                sl[lane * 36 + b] = sv; }
            asm volatile("s_waitcnt lgkmcnt(0)" ::: "memory");
#pragma unroll 1
            for (int k = 0; k < 64; ++k) { const float wv = a.in[I_WADA][(size_t)(k0 + k) * 6144 + j0 + lane];
                const LAS f32x4* sp = (const LAS f32x4*)(sl + k * 36);
#pragma unroll
                for (int q = 0; q < 9; ++q) { const f32x4 s4 = sp[q]; acc[4 * q] += s4[0] * wv; acc[4 * q + 1] += s4[1] * wv; acc[4 * q + 2] += s4[2] * wv; acc[4 * q + 3] += s4[3] * wv; } }
            asm volatile("s_waitcnt lgkmcnt(0)" ::: "memory");
        }
        __syncthreads();
        LAS float* ex = (LAS float*)lds;
#pragma unroll
        for (int b = 0; b < NSEQ; ++b) ex[wave * (NSEQ * 64) + b * 64 + lane] = acc[b];
        __syncthreads();
        for (int idx = threadIdx.x; idx < NSEQ * 64; idx += 512) { float sm = a.in[I_BADA][j0 + (idx & 63)];
#pragma unroll
            for (int w = 0; w < 8; ++w) sm += ex[w * (NSEQ * 64) + idx];
            MOD[(size_t)(idx >> 6) * 6144 + j0 + (idx & 63)] = sm; }
        __syncthreads();
    }
}

__device__ void phase_norm(const Args& a, const float* xp, const float* xs, const float* g, int sh_off, int sc_off) {
    const float* MOD = (const float*)(a.ws + OFF_MOD); bf16_t* H = (bf16_t*)(a.ws + OFF_H);
    const int wave = threadIdx.x >> 6, lane = threadIdx.x & 63;
    for (int row = blockIdx.x * 8 + wave; row < NTOK; row += gridDim.x * 8) {
        const float* xr = (row < NP) ? xp + (size_t)row * DM : xs + (size_t)(row - NP) * DM;
        const float* mr = MOD + (size_t)seq_of_row(row) * 6144;
        f32x4 v[4]; float ss = 0.f;
#pragma unroll
        for (int i = 0; i < 4; ++i) { v[i] = __builtin_nontemporal_load((const f32x4*)(xr + i * 256 + lane * 4)); ss += v[i][0] * v[i][0] + v[i][1] * v[i][1] + v[i][2] * v[i][2] + v[i][3] * v[i][3]; }
        ss = wave_sum(ss);
        const float rinv = rsqrtf(ss * (1.f / DM) + NORM_EPS);
#pragma unroll
        for (int i = 0; i < 4; ++i) { const int c = i * 256 + lane * 4;
            const f32x4 gg = *(const f32x4*)(g + c), sc = *(const f32x4*)(mr + sc_off + c), sh = *(const f32x4*)(mr + sh_off + c);
            f32x4 h;
#pragma unroll
            for (int j = 0; j < 4; ++j) h[j] = v[i][j] * rinv * gg[j] * (1.f + sc[j]) + sh[j];
            u32x2 w; w.x = cvt_pk_bf16(h[0], h[1]); w.y = cvt_pk_bf16(h[2], h[3]);
            *(u32x2*)(H + (size_t)row * DM + c) = w; }
    }
}

__device__ void phase_post_in(const Args& a) {
    const bf16_t* PR = (const bf16_t*)(a.ws + OFF_PR); bf16_t* X5 = (bf16_t*)(a.ws + OFF_X5);
    const int wave = threadIdx.x >> 6, lane = threadIdx.x & 63;
    const int c0 = (lane < 48 ? lane : 0) * 8;
    float mp[8], mn[8];
#pragma unroll
    for (int j = 0; j < 8; ++j) { mp[j] = a.in[I_MUP][1536 + c0 + j]; mn[j] = a.in[I_MUN][1536 + c0 + j]; }
    const int nw = gridDim.x * 8;
    for (int row = blockIdx.x * 8 + wave; row < NTOK; row += 2 * nw) {
        const int row2 = (row + nw < NTOK) ? row + nw : row;
        u32x4 cu[2], pv[2], nx[2]; int rr[2]; rr[0] = row; rr[1] = row2;
#pragma unroll
        for (int q = 0; q < 2; ++q) { const int r = rr[q];
            int pos, S; if (r < NP) { pos = r; S = NP; } else { pos = (r - NP) % SS; S = SS; }
            const bf16_t* pr = PR + (size_t)r * 1920 + 1536 + c0;
            cu[q] = *(const u32x4*)pr;
            pv[q] = pos > 0 ? *(const u32x4*)(pr - 1920) : (u32x4){0u, 0u, 0u, 0u};
            nx[q] = pos < S - 1 ? *(const u32x4*)(pr + 1920) : (u32x4){0u, 0u, 0u, 0u}; }
#pragma unroll
        for (int q = 0; q < 2; ++q) {
            if (q == 1 && row2 == row) break;
            float x[8];
#pragma unroll
            for (int j = 0; j < 4; ++j) { const float c_lo = lo_bf(cu[q][j]), c_hi = hi_bf(cu[q][j]);
                x[2 * j] = c_lo + mp[2 * j] * (lo_bf(pv[q][j]) - c_lo) + mn[2 * j] * (lo_bf(nx[q][j]) - c_lo);
                x[2 * j + 1] = c_hi + mp[2 * j + 1] * (hi_bf(pv[q][j]) - c_hi) + mn[2 * j + 1] * (hi_bf(nx[q][j]) - c_hi); }
            if (lane < 16) {
#pragma unroll
                for (int j = 0; j < 8; ++j) x[j] = tanhf(x[j]);
            } else if (lane >= 32) {
#pragma unroll
                for (int j = 0; j < 8; ++j) x[j] = 1.f / (1.f + __expf(-x[j]));
            }
            u32x4 w; w.x = cvt_pk_bf16(x[0], x[1]); w.y = cvt_pk_bf16(x[2], x[3]); w.z = cvt_pk_bf16(x[4], x[5]); w.w = cvt_pk_bf16(x[6], x[7]);
            if (lane < 48) *(u32x4*)(X5 + (size_t)rr[q] * 384 + c0) = w;
        }
    }
}

__device__ void attn_job4(const Args& a, LAS bf16_t* vlb, int row0, int S, int h, int q0a, float cshift) {
    const bf16_t* QKV = (const bf16_t*)a.out; bf16_t* MIX = (bf16_t*)(a.ws + OFF_H);
    const int lane = threadIdx.x & 63, fr = lane & 15, g = lane >> 4;
    const float slope = exp2f(-(float)(h + 1));
    constexpr int VP = 64;
    const bf16_t* kbase = QKV + (size_t)row0 * 1536 + 512 + h * 64 + g * 8;
    const bf16_t* vbase = QKV + (size_t)row0 * 1536 + 1024 + h * 64;
    int qp[4]; f32x4 O[4][4]; float l[4];
    LAS bf16x8* qlds = (LAS bf16x8*)(vlb + 2 * 32 * VP);
    asm volatile("s_waitcnt lgkmcnt(0)" ::: "memory");
#pragma unroll
    for (int jj = 0; jj < 4; ++jj) { qp[jj] = q0a + 4 * jj + 16 * fr;
        const bf16_t* qrow = QKV + (size_t)(row0 + qp[jj]) * 1536 + h * 64;
        qlds[(jj * 2 + 0) * 64 + lane] = *(const bf16x8*)(qrow + g * 8); qlds[(jj * 2 + 1) * 64 + lane] = *(const bf16x8*)(qrow + 32 + g * 8); l[jj] = 0.f;
#pragma unroll
        for (int i = 0; i < 4; ++i) O[jj][i] = (f32x4){0.f, 0.f, 0.f, 0.f}; }
    bf16x8 nka0[2], nka1[2], nkb0[2], nkb1[2]; u32x4 nvv[2][4];
    const float slope2 = slope * 1.44269504f, c2 = cshift * 1.44269504f;
    const unsigned traddr = (unsigned)(unsigned long)vlb + (unsigned)((8 * g + ((lane & 15) >> 2)) * (VP * 2) + 8 * (lane & 3));
#define LOAD_SET(KJ, Q0S, D_, TP_) { const int base_ = (Q0S) - 64 * (D_); \
        int kpa = base_ + (D_) * (16 * (TP_) + fr), kpb = kpa + 16 * (D_); kpa = min(max(kpa, 0), S - 1); kpb = min(max(kpb, 0), S - 1); \
        const bf16_t* ka = kbase + (size_t)kpa * 1536; const bf16_t* kb = kbase + (size_t)kpb * 1536; \
        nka0[KJ] = *(const bf16x8*)ka; nka1[KJ] = *(const bf16x8*)(ka + 32); nkb0[KJ] = *(const bf16x8*)kb; nkb1[KJ] = *(const bf16x8*)(kb + 32); \
        _Pragma("unroll") for (int i = 0; i < 4; ++i) { const int idx = lane + 64 * i, rr = idx >> 3, chk = idx & 7; \
            int kp = base_ + (D_) * (16 * (TP_) + rr); kp = min(max(kp, 0), S - 1); nvv[KJ][i] = *(const u32x4*)(vbase + (size_t)kp * 1536 + chk * 8); } }
#define V_TO_LDS(KJ) _Pragma("unroll") for (int i = 0; i < 4; ++i) { const int idx = lane + 64 * i, rr = idx >> 3, chk = idx & 7; \
            const int rho = 8 * ((rr & 15) >> 2) + 4 * (rr >> 4) + (rr & 3); \
            *(LAS u32x4*)(vlb + (KJ) * (32 * VP) + rho * VP + chk * 8) = nvv[KJ][i]; }
#define QK_SOFTMAX(JJ, KJ, SHIFT, D_, TP_, PF) { \
        const bf16x8 q0_ = qlds[((JJ) * 2 + 0) * 64 + lane], q1_ = qlds[((JJ) * 2 + 1) * 64 + lane]; \
        f32x4 sa_ = __builtin_amdgcn_mfma_f32_16x16x32_bf16(nka0[KJ], q0_, (f32x4){0.f, 0.f, 0.f, 0.f}, 0, 0, 0); sa_ = __builtin_amdgcn_mfma_f32_16x16x32_bf16(nka1[KJ], q1_, sa_, 0, 0, 0); \
        f32x4 sb_ = __builtin_amdgcn_mfma_f32_16x16x32_bf16(nkb0[KJ], q0_, (f32x4){0.f, 0.f, 0.f, 0.f}, 0, 0, 0); sb_ = __builtin_amdgcn_mfma_f32_16x16x32_bf16(nkb1[KJ], q1_, sb_, 0, 0, 0); \
        const float fd_ = (float)(D_); \
        const float fR0 = (float)((D_) * (16 * (TP_) + 4 * g - 64) - 16 * fr) - (float)(SHIFT); \
        const float lo = fmaxf(-64.f * fd_, -(float)qp[JJ]), hi = fminf(64.f * fd_, (float)(S - 1 - qp[JJ])); \
        float pa[4], pb[4]; \
        _Pragma("unroll") for (int j = 0; j < 4; ++j) { \
            const float r1 = fR0 + (float)j * fd_, r2 = r1 + 16.f * fd_; \
            const float e1 = __builtin_amdgcn_exp2f(__builtin_fmaf(-slope2, fabsf(r1), __builtin_fmaf(sa_[j], 1.44269504f, -c2))); \
            const float e2 = __builtin_amdgcn_exp2f(__builtin_fmaf(-slope2, fabsf(r2), __builtin_fmaf(sb_[j], 1.44269504f, -c2))); \
            pa[j] = (r1 >= lo && r1 <= hi) ? e1 : 0.f; pb[j] = (r2 >= lo && r2 <= hi) ? e2 : 0.f; \
            l[JJ] += pa[j] + pb[j]; } \
        u32x4 pw; pw.x = cvt_pk_bf16(pa[0], pa[1]); pw.y = cvt_pk_bf16(pa[2], pa[3]); pw.z = cvt_pk_bf16(pb[0], pb[1]); pw.w = cvt_pk_bf16(pb[2], pb[3]); \
        __builtin_memcpy(&PF, &pw, 16); }
#define TR_READ2(KJ, DB0, TV) { _Pragma("unroll") for (int db = 0; db < 2; ++db) _Pragma("unroll") for (int t = 0; t < 2; ++t) \
            asm volatile("ds_read_b64_tr_b16 %0, %1" : "=v"(TV[db][t]) : "v"(traddr + (unsigned)((KJ) * (32 * VP * 2) + t * (4 * VP * 2) + ((DB0) + db) * 32))); \
        asm volatile("s_waitcnt lgkmcnt(0)" : "+v"(TV[0][0]), "+v"(TV[0][1]), "+v"(TV[1][0]), "+v"(TV[1][1]) :: "memory"); }
#define PV2(JJ, DB0, TV, PF) _Pragma("unroll") for (int db = 0; db < 2; ++db) { \
            u32x4 vw; vw.x = TV[db][0].x; vw.y = TV[db][0].y; vw.z = TV[db][1].x; vw.w = TV[db][1].y; \
            bf16x8 vf; __builtin_memcpy(&vf, &vw, 16); \
            O[JJ][(DB0) + db] = __builtin_amdgcn_mfma_f32_16x16x32_bf16(vf, PF, O[JJ][(DB0) + db], 0, 0, 0); }
    LOAD_SET(0, q0a, 1, 0)
    for (int st = 0; st < 18; ++st) {
        const int d = st < 12 ? 1 : 4, tp = st < 12 ? 2 * st : 2 * (st - 12);
        bf16x8 pf0, pf1, pf2, pf3;
        QK_SOFTMAX(0, 0, 0, d, tp, pf0) QK_SOFTMAX(1, 0, 4, d, tp, pf1) QK_SOFTMAX(2, 0, 8, d, tp, pf2) QK_SOFTMAX(3, 0, 12, d, tp, pf3)
        asm volatile("s_waitcnt lgkmcnt(0)" ::: "memory");
        V_TO_LDS(0)
        asm volatile("" ::: "memory");
        if (st + 1 < 18) { const int sn = st + 1, dn = sn < 12 ? 1 : 4, tn = sn < 12 ? 2 * sn : 2 * (sn - 12); LOAD_SET(0, q0a, dn, tn) }
        else { LOAD_SET(0, q0a, 16, 0) }
        asm volatile("s_waitcnt lgkmcnt(0)" ::: "memory");
        u32x2 tv[2][2];
        TR_READ2(0, 0, tv) PV2(0, 0, tv, pf0) PV2(1, 0, tv, pf1) PV2(2, 0, tv, pf2) PV2(3, 0, tv, pf3)
        TR_READ2(0, 2, tv) PV2(0, 2, tv, pf0) PV2(1, 2, tv, pf1) PV2(2, 2, tv, pf2) PV2(3, 2, tv, pf3)
    }
    LOAD_SET(1, q0a + 4, 16, 0)
    for (int s5 = 0; s5 < 5; ++s5) {
        const int tp = 2 * s5;
        {   bf16x8 pfa, pfb;
            QK_SOFTMAX(0, 0, 0, 16, tp, pfa) QK_SOFTMAX(1, 1, 0, 16, tp, pfb)
            asm volatile("s_waitcnt lgkmcnt(0)" ::: "memory");
            V_TO_LDS(0) V_TO_LDS(1)
            asm volatile("" ::: "memory");
            LOAD_SET(0, q0a + 8, 16, tp) LOAD_SET(1, q0a + 12, 16, tp)
            asm volatile("s_waitcnt lgkmcnt(0)" ::: "memory");
            u32x2 tv[2][2];
            TR_READ2(0, 0, tv) PV2(0, 0, tv, pfa) TR_READ2(0, 2, tv) PV2(0, 2, tv, pfa)
            TR_READ2(1, 0, tv) PV2(1, 0, tv, pfb) TR_READ2(1, 2, tv) PV2(1, 2, tv, pfb) }
        {   bf16x8 pfa, pfb;
            QK_SOFTMAX(2, 0, 0, 16, tp, pfa) QK_SOFTMAX(3, 1, 0, 16, tp, pfb)
            asm volatile("s_waitcnt lgkmcnt(0)" ::: "memory");
            V_TO_LDS(0) V_TO_LDS(1)
            asm volatile("" ::: "memory");
            { const int tn = s5 < 4 ? tp + 2 : tp; LOAD_SET(0, q0a, 16, tn) LOAD_SET(1, q0a + 4, 16, tn) }
            asm volatile("s_waitcnt lgkmcnt(0)" ::: "memory");
            u32x2 tv[2][2];
            TR_READ2(0, 0, tv) PV2(2, 0, tv, pfa) TR_READ2(0, 2, tv) PV2(2, 2, tv, pfa)
            TR_READ2(1, 0, tv) PV2(3, 0, tv, pfb) TR_READ2(1, 2, tv) PV2(3, 2, tv, pfb) }
    }
#undef LOAD_SET
#undef V_TO_LDS
#undef QK_SOFTMAX
#undef TR_READ2
#undef PV2
    const float* beta = a.in[I_BETA] + h * 64;
#pragma unroll
    for (int jj = 0; jj < 4; ++jj) {
        float ls = l[jj]; ls += __shfl_xor(ls, 16); ls += __shfl_xor(ls, 32);
        const float inv = 1.f / ls;
        bf16_t* op = MIX + (size_t)(row0 + qp[jj]) * DM + h * 64;
#pragma unroll
        for (int db = 0; db < 4; ++db) { const int dd = 16 * db + 4 * g;
            u32x2 w; w.x = cvt_pk_bf16(O[jj][db][0] * inv * beta[dd], O[jj][db][1] * inv * beta[dd + 1]); w.y = cvt_pk_bf16(O[jj][db][2] * inv * beta[dd + 2], O[jj][db][3] * inv * beta[dd + 3]);
            *(u32x2*)(op + dd) = w; }
    }
}
__device__ void phase_attn(const Args& a, LAS unsigned char* lds) {
    const int wave = threadIdx.x >> 6, lane = threadIdx.x & 63;
    LAS bf16_t* vl = (LAS bf16_t*)(lds + wave * 16384);
    const float gq = wave_max(fabsf(a.in[I_QG][lane])), gk = wave_max(fabsf(a.in[I_KG][lane]));
    const float cshift = 8.f * gq * gk;
    const int njobs = (NTOK / 256) * 8 * 4;
    for (int j = blockIdx.x * 8 + wave; j < njobs; j += gridDim.x * 8) {
        const int r = j & 3, h = (j >> 2) & 7, tb = j >> 5;
        const int rowb = tb * 256;
        int row0, S; if (rowb < NP) { row0 = 0; S = NP; } else { row0 = NP + ((rowb - NP) / SS) * SS; S = SS; }
        attn_job4(a, vl, row0, S, h, rowb - row0 + r, cshift);
    }
}

__device__ __forceinline__ float dpp_x1(float x) { return __int_as_float(__builtin_amdgcn_update_dpp(0, __float_as_int(x), 0xB1, 0xF, 0xF, true)); }
__device__ __forceinline__ float dpp_x2(float x) { return __int_as_float(__builtin_amdgcn_update_dpp(0, __float_as_int(x), 0x4E, 0xF, 0xF, true)); }
__device__ __forceinline__ float quad_sum(float x) { x += dpp_x1(x); x += dpp_x2(x); return x; }
constexpr int SEG = 256, NSEGP = NP / SEG;

template <int MODE>
__device__ void scan_job(const Args& a, LAS float* wl, int row0, int S, int h, int dir, int i0, int n, const float* startp, float* endp, bool emit) {
    const bf16_t* PR = (const bf16_t*)(a.ws + OFF_PR); const bf16_t* LORA = (const bf16_t*)(a.ws + OFF_LORA);
    bf16_t* Y = (bf16_t*)(a.ws + OFF_Y); float* CB = (float*)(a.ws + OFF_C);
    const int lane = threadIdx.x & 63, ch = h * 64 + lane, qd = lane >> 2, kq = lane & 3;
    const float mpr_r = a.in[I_MUP][ch], mnx_r = a.in[I_MUN][ch], mpr_k = a.in[I_MUP][512 + ch], mnx_k = a.in[I_MUN][512 + ch], mpr_v = a.in[I_MUP][1024 + ch], mnx_v = a.in[I_MUN][1024 + ch];
    const float kkc = a.in[I_KK][ch], kac = a.in[I_KA][ch], rkc = a.in[I_RK][ch];
    const float w0c = a.in[I_W0][dir * 512 + ch], a0c = a.in[I_A0][dir * 512 + ch];
    f32x2 St[4][8];
#pragma unroll
    for (int i = 0; i < 4; ++i)
#pragma unroll
        for (int k2 = 0; k2 < 8; ++k2) {
            if (MODE == 1) { const int r = 4 * qd + i, c = kq * 16 + 2 * k2; St[i][k2] = (f32x2){r == c ? 1.f : 0.f, r == c + 1 ? 1.f : 0.f}; }
            else if (startp) St[i][k2] = *(const f32x2*)(startp + (4 * qd + i) * 64 + kq * 16 + 2 * k2);
            else St[i][k2] = (f32x2){0.f, 0.f};
        }
    const int sd = dir ? -1 : 1;
    const int t0 = dir ? S - 1 - i0 : i0;
    float rb = 0.f, kb = 0.f, vb = 0.f, rc, kc, vc, ra = 0.f, ka = 0.f, va = 0.f;
    { const bf16_t* p = PR + (size_t)(row0 + t0) * 1920 + ch; rc = bf2f(p[0]); kc = bf2f(p[512]); vc = bf2f(p[1024]);
      const int tb = t0 - sd, ta = t0 + sd;
      if (tb >= 0 && tb < S) { const bf16_t* q = PR + (size_t)(row0 + tb) * 1920 + ch; rb = bf2f(q[0]); kb = bf2f(q[512]); vb = bf2f(q[1024]); }
      if (ta >= 0 && ta < S) { const bf16_t* q = PR + (size_t)(row0 + ta) * 1920 + ch; ra = bf2f(q[0]); ka = bf2f(q[512]); va = bf2f(q[1024]); } }
    bf16_t nr[4], nk[4], nv[4], lw[4], la[4];
#define SCAN_LOADS(IB, R_, K_, V_, W_, A_) _Pragma("unroll") for (int u = 0; u < 4; ++u) { const int t = t0 + sd * ((IB) + u), t2 = t + 2 * sd; const bool ok = (t2 >= 0 && t2 < S); \
            const bf16_t* p = PR + (size_t)(row0 + (ok ? t2 : t)) * 1920 + ch; \
            R_[u] = ok ? p[0] : (bf16_t)0; K_[u] = ok ? p[512] : (bf16_t)0; V_[u] = ok ? p[1024] : (bf16_t)0; \
            const bf16_t* lp = LORA + (size_t)(row0 + t) * 2048 + dir * 512 + ch; W_[u] = lp[0]; A_[u] = lp[1024]; }
    SCAN_LOADS(0, nr, nk, nv, lw, la)
    for (int ib = 0; ib < n; ib += 4) {
        bf16_t pr_[4], pk_[4], pv_[4], pw_[4], pa_[4];
        { const int ibn = (ib + 4 < n) ? ib + 4 : ib; SCAN_LOADS(ibn, pr_, pk_, pv_, pw_, pa_) }
#pragma unroll
        for (int u = 0; u < 4; ++u) {
            const int t = t0 + sd * (ib + u);
            const float rp = dir ? ra : rb, rn = dir ? rb : ra, kp = dir ? ka : kb, kn = dir ? kb : ka, vp = dir ? va : vb, vn = dir ? vb : va;
            const float r = rc + mpr_r * (rp - rc) + mnx_r * (rn - rc);
            const float k = kc + mpr_k * (kp - kc) + mnx_k * (kn - kc);
            const float v = vc + mpr_v * (vp - vc) + mnx_v * (vn - vc);
            const float wraw = bf2f(lw[u]) + w0c, apre = bf2f(la[u]) + a0c;
            const float w = __expf(-0.60653066f * __builtin_amdgcn_rcpf(1.f + __expf(-wraw)));
            const float av = __builtin_amdgcn_rcpf(1.f + __expf(-apre));
            const float kkr = k * kkc; const float ssq = wave_sum(kkr * kkr);
            const float kk = kkr * rsqrtf(fmaxf(ssq, 1e-24f));
            const float kd = k * (1.f + (av - 1.f) * kac);
            const float bb = kk * av;
            LAS float* o = wl + u * 384;
            o[lane] = w; o[64 + lane] = kk; o[128 + lane] = bb; o[192 + lane] = kd; o[256 + lane] = r; o[320 + lane] = v;
            if (emit) { const float cd = wave_sum(r * kd * rkc); if (lane == 0) CB[((size_t)dir * NTOK + row0 + t) * 8 + h] = cd; }
            rb = rc; kb = kc; vb = vc; rc = ra; kc = ka; vc = va; ra = bf2f(nr[u]); ka = bf2f(nk[u]); va = bf2f(nv[u]);
        }
        asm volatile("s_waitcnt lgkmcnt(0)" ::: "memory");
#pragma unroll
        for (int u = 0; u < 4; ++u) {
            const LAS f32x4* V4 = (const LAS f32x4*)(wl + u * 384);
            f32x4 k4[4];
#pragma unroll
            for (int j = 0; j < 4; ++j) k4[j] = V4[16 + kq * 4 + j];
            float sa[4];
#pragma unroll
            for (int i = 0; i < 4; ++i) { f32x2 a2 = (f32x2){0.f, 0.f};
#pragma unroll
                for (int j = 0; j < 4; ++j) { a2 += St[i][2 * j] * (f32x2){k4[j][0], k4[j][1]}; a2 += St[i][2 * j + 1] * (f32x2){k4[j][2], k4[j][3]}; }
                sa[i] = quad_sum(a2[0] + a2[1]); }
            f32x4 w4[4], b4[4], d4[4], r4[4];
#pragma unroll
            for (int j = 0; j < 4; ++j) { w4[j] = V4[kq * 4 + j]; b4[j] = V4[32 + kq * 4 + j]; if (MODE == 0) { d4[j] = V4[48 + kq * 4 + j]; r4[j] = V4[64 + kq * 4 + j]; } }
            f32x4 vr = (f32x4){0.f, 0.f, 0.f, 0.f};
            if (MODE == 0) vr = V4[80 + qd];
            float yv[4];
#pragma unroll
            for (int i = 0; i < 4; ++i) {
                const f32x2 nsa = (f32x2){-sa[i], -sa[i]}, vv2 = (f32x2){vr[i], vr[i]};
                f32x2 y2 = (f32x2){0.f, 0.f};
#pragma unroll
                for (int j = 0; j < 4; ++j) {
                    f32x2 ta = nsa * (f32x2){b4[j][0], b4[j][1]}, tb = nsa * (f32x2){b4[j][2], b4[j][3]};
                    if (MODE == 0) { ta += vv2 * (f32x2){d4[j][0], d4[j][1]}; tb += vv2 * (f32x2){d4[j][2], d4[j][3]}; }
                    St[i][2 * j] = St[i][2 * j] * (f32x2){w4[j][0], w4[j][1]} + ta; St[i][2 * j + 1] = St[i][2 * j + 1] * (f32x2){w4[j][2], w4[j][3]} + tb;
                    if (MODE == 0) { y2 += St[i][2 * j] * (f32x2){r4[j][0], r4[j][1]}; y2 += St[i][2 * j + 1] * (f32x2){r4[j][2], r4[j][3]}; }
                }
                yv[i] = y2[0] + y2[1];
            }
            if (MODE == 0 && emit) {
#pragma unroll
                for (int i = 0; i < 4; ++i) yv[i] = quad_sum(yv[i]);
                const int t = t0 + sd * (ib + u);
                if (kq == 0) { u32x2 w; w.x = cvt_pk_bf16(yv[0], yv[1]); w.y = cvt_pk_bf16(yv[2], yv[3]);
                    *(u32x2*)(Y + ((size_t)dir * NTOK + row0 + t) * 512 + h * 64 + 4 * qd) = w; }
            }
        }
        asm volatile("s_waitcnt lgkmcnt(0)" ::: "memory");
#pragma unroll
        for (int u = 0; u < 4; ++u) { nr[u] = pr_[u]; nk[u] = pk_[u]; nv[u] = pv_[u]; lw[u] = pw_[u]; la[u] = pa_[u]; }
    }
#undef SCAN_LOADS
    if (endp) {
#pragma unroll
        for (int i = 0; i < 4; ++i)
#pragma unroll
            for (int k2 = 0; k2 < 8; ++k2) *(f32x2*)(endp + (4 * qd + i) * 64 + kq * 16 + 2 * k2) = St[i][k2];
    }
}
__device__ __forceinline__ float* sum_slot(const Args& a, int chain, int seg, int which) { return (float*)(a.ws + OFF_SUM) + ((size_t)(chain * NSEGP + seg) * 2 + which) * 4096; }

__device__ void scan_job_pq(const Args& a, LAS float* wl, int row0, int S, int h, int dir, int i0, int n, int half, float* endP, float* endQ) {
    const bf16_t* PR = (const bf16_t*)(a.ws + OFF_PR); const bf16_t* LORA = (const bf16_t*)(a.ws + OFF_LORA);
    const int lane = threadIdx.x & 63, ch = h * 64 + lane, qd = lane >> 2, kq = lane & 3;
    const float mpr_k = a.in[I_MUP][512 + ch], mnx_k = a.in[I_MUN][512 + ch], mpr_v = a.in[I_MUP][1024 + ch], mnx_v = a.in[I_MUN][1024 + ch];
    const float kkc = a.in[I_KK][ch], kac = a.in[I_KA][ch];
    const float w0c = a.in[I_W0][dir * 512 + ch], a0c = a.in[I_A0][dir * 512 + ch];
    f32x2 Sp[2][8], Sq[2][8];
#pragma unroll
    for (int i = 0; i < 2; ++i)
#pragma unroll
        for (int k2 = 0; k2 < 8; ++k2) { const int r = 4 * qd + 2 * half + i, c = kq * 16 + 2 * k2; Sp[i][k2] = (f32x2){r == c ? 1.f : 0.f, r == c + 1 ? 1.f : 0.f}; Sq[i][k2] = (f32x2){0.f, 0.f}; }
    const int sd = dir ? -1 : 1;
    const int t0 = dir ? S - 1 - i0 : i0;
    float kb = 0.f, vb = 0.f, kc, vc, ka = 0.f, va = 0.f;
    { const bf16_t* p = PR + (size_t)(row0 + t0) * 1920 + ch; kc = bf2f(p[512]); vc = bf2f(p[1024]);
      const int tb = t0 - sd, ta = t0 + sd;
      if (tb >= 0 && tb < S) { const bf16_t* q = PR + (size_t)(row0 + tb) * 1920 + ch; kb = bf2f(q[512]); vb = bf2f(q[1024]); }
      if (ta >= 0 && ta < S) { const bf16_t* q = PR + (size_t)(row0 + ta) * 1920 + ch; ka = bf2f(q[512]); va = bf2f(q[1024]); } }
    bf16_t nk[4], nv[4], lw[4], la[4];
#define PQ_LOADS(IB, K_, V_, W_, A_) _Pragma("unroll") for (int u = 0; u < 4; ++u) { const int t = t0 + sd * ((IB) + u), t2 = t + 2 * sd; const bool ok = (t2 >= 0 && t2 < S); \
            const bf16_t* p = PR + (size_t)(row0 + (ok ? t2 : t)) * 1920 + ch; \
            K_[u] = ok ? p[512] : (bf16_t)0; V_[u] = ok ? p[1024] : (bf16_t)0; \
            const bf16_t* lp = LORA + (size_t)(row0 + t) * 2048 + dir * 512 + ch; W_[u] = lp[0]; A_[u] = lp[1024]; }
    PQ_LOADS(0, nk, nv, lw, la)
    for (int ib = 0; ib < n; ib += 4) {
        bf16_t pk_[4], pv_[4], pw_[4], pa_[4];
        { const int ibn = (ib + 4 < n) ? ib + 4 : ib; PQ_LOADS(ibn, pk_, pv_, pw_, pa_) }
#pragma unroll
        for (int u = 0; u < 4; ++u) {
            const float kp = dir ? ka : kb, kn = dir ? kb : ka, vp = dir ? va : vb, vn = dir ? vb : va;
            const float k = kc + mpr_k * (kp - kc) + mnx_k * (kn - kc);
            const float v = vc + mpr_v * (vp - vc) + mnx_v * (vn - vc);
            const float wraw = bf2f(lw[u]) + w0c, apre = bf2f(la[u]) + a0c;
            const float w = __expf(-0.60653066f * __builtin_amdgcn_rcpf(1.f + __expf(-wraw)));
            const float av = __builtin_amdgcn_rcpf(1.f + __expf(-apre));
            const float kkr = k * kkc; const float ssq = wave_sum(kkr * kkr);
            const float kk = kkr * rsqrtf(fmaxf(ssq, 1e-24f));
            const float kd = k * (1.f + (av - 1.f) * kac);
            const float bb = kk * av;
            LAS float* o = wl + u * 384;
            o[lane] = w; o[64 + lane] = kk; o[128 + lane] = bb; o[192 + lane] = kd; o[320 + lane] = v;
            kb = kc; vb = vc; kc = ka; vc = va; ka = bf2f(nk[u]); va = bf2f(nv[u]);
        }
        asm volatile("s_waitcnt lgkmcnt(0)" ::: "memory");
#pragma unroll
        for (int u = 0; u < 4; ++u) {
            const LAS f32x4* V4 = (const LAS f32x4*)(wl + u * 384);
            __builtin_amdgcn_sched_barrier(0);
            f32x4 k4[4], w4[4], b4[4], d4[4];
#pragma unroll
            for (int j = 0; j < 4; ++j) k4[j] = V4[16 + kq * 4 + j];
            float sap[2], saq[2];
#pragma unroll
            for (int i = 0; i < 2; ++i) { f32x2 ap = (f32x2){0.f, 0.f}, aq = (f32x2){0.f, 0.f};
#pragma unroll
                for (int j = 0; j < 4; ++j) { ap += Sp[i][2 * j] * (f32x2){k4[j][0], k4[j][1]}; ap += Sp[i][2 * j + 1] * (f32x2){k4[j][2], k4[j][3]};
                                              aq += Sq[i][2 * j] * (f32x2){k4[j][0], k4[j][1]}; aq += Sq[i][2 * j + 1] * (f32x2){k4[j][2], k4[j][3]}; }
                sap[i] = quad_sum(ap[0] + ap[1]); saq[i] = quad_sum(aq[0] + aq[1]); }
            __builtin_amdgcn_sched_barrier(0);
#pragma unroll
            for (int j = 0; j < 4; ++j) { w4[j] = V4[kq * 4 + j]; b4[j] = V4[32 + kq * 4 + j]; d4[j] = V4[48 + kq * 4 + j]; }
            const f32x4 vr = V4[80 + qd];
#pragma unroll
            for (int i = 0; i < 2; ++i) {
                const float vsel = half ? (i ? vr[3] : vr[2]) : (i ? vr[1] : vr[0]);
                const f32x2 nsp = (f32x2){-sap[i], -sap[i]}, nsq = (f32x2){-saq[i], -saq[i]}, vv2 = (f32x2){vsel, vsel};
#pragma unroll
                for (int j = 0; j < 4; ++j) {
                    const f32x2 blo = (f32x2){b4[j][0], b4[j][1]}, bhi = (f32x2){b4[j][2], b4[j][3]}, wlo = (f32x2){w4[j][0], w4[j][1]}, whi = (f32x2){w4[j][2], w4[j][3]};
                    Sp[i][2 * j] = Sp[i][2 * j] * wlo + nsp * blo; Sp[i][2 * j + 1] = Sp[i][2 * j + 1] * whi + nsp * bhi;
                    Sq[i][2 * j] = Sq[i][2 * j] * wlo + (vv2 * (f32x2){d4[j][0], d4[j][1]} + nsq * blo); Sq[i][2 * j + 1] = Sq[i][2 * j + 1] * whi + (vv2 * (f32x2){d4[j][2], d4[j][3]} + nsq * bhi);
                }
            }
        }
        asm volatile("s_waitcnt lgkmcnt(0)" ::: "memory");
#pragma unroll
        for (int u = 0; u < 4; ++u) { nk[u] = pk_[u]; nv[u] = pv_[u]; lw[u] = pw_[u]; la[u] = pa_[u]; }
    }
#undef PQ_LOADS
#pragma unroll
    for (int i = 0; i < 2; ++i)
#pragma unroll
        for (int k2 = 0; k2 < 8; ++k2) { *(f32x2*)(endP + (4 * qd + 2 * half + i) * 64 + kq * 16 + 2 * k2) = Sp[i][k2]; *(f32x2*)(endQ + (4 * qd + 2 * half + i) * 64 + kq * 16 + 2 * k2) = Sq[i][k2]; }
}
__device__ void phase_scan_pass1(const Args& a, LAS unsigned char* lds) {
    const int wave = threadIdx.x >> 6;
    LAS float* wl = (LAS float*)(lds + wave * 16384);
    const int njobs = 16 * (NSEGP - 1) * 2;
    for (int j = blockIdx.x * 8 + wave; j < njobs; j += gridDim.x * 8) {
        const int chain = j / ((NSEGP - 1) * 2), rem = j % ((NSEGP - 1) * 2), seg = rem >> 1, half = rem & 1;
        scan_job_pq(a, wl, 0, NP, chain >> 1, chain & 1, seg * SEG, SEG, half, sum_slot(a, chain, seg, 0), sum_slot(a, chain, seg, 1));
    }
}
__device__ void combine_chain(const Args& a, LAS unsigned char* lds, int chain, int q) {
    LAS float* Ss = (LAS float*)lds;
    LAS float* Ps = (LAS float*)(lds + 8192);
    const int tid = threadIdx.x, vl = tid >> 5, v = 16 * q + vl, kb = (tid & 31) * 2;
    { const float* q0 = sum_slot(a, chain, 0, 1);
      for (int i = tid; i < 1024; i += 512) Ss[(i >> 6) * 65 + (i & 63)] = q0[(16 * q + (i >> 6)) * 64 + (i & 63)]; }
    f32x4 np0, np1; f32x2 nc;
    { const float* pj = sum_slot(a, chain, 1, 0); const float* qj = sum_slot(a, chain, 1, 1);
      np0 = *(const f32x4*)(pj + tid * 4); np1 = *(const f32x4*)(pj + 2048 + tid * 4); nc = *(const f32x2*)(qj + v * 64 + kb); }
    for (int j = 1; j < NSEGP - 1; ++j) {
        float* qj = sum_slot(a, chain, j, 1);
        *(LAS f32x4*)(Ps + tid * 4) = np0; *(LAS f32x4*)(Ps + 2048 + tid * 4) = np1;
        f32x2 c = nc;
        if (j + 1 < NSEGP - 1) { const float* pn = sum_slot(a, chain, j + 1, 0); const float* qn = sum_slot(a, chain, j + 1, 1);
            np0 = *(const f32x4*)(pn + tid * 4); np1 = *(const f32x4*)(pn + 2048 + tid * 4); nc = *(const f32x2*)(qn + v * 64 + kb); }
        __syncthreads();
#pragma unroll 16
        for (int m = 0; m < 64; ++m) { const float sv = Ss[vl * 65 + m]; const f32x2 p = *(const LAS f32x2*)(Ps + m * 64 + kb); c += sv * p; }
        __syncthreads();
        *(f32x2*)(qj + v * 64 + kb) = c;
        Ss[vl * 65 + kb] = c[0]; Ss[vl * 65 + kb + 1] = c[1];
    }
    __threadfence();
    __syncthreads();
    if (tid == 0) __hip_atomic_fetch_add((int*)(a.ws + OFF_FLAG) + chain, 1, __ATOMIC_RELEASE, __HIP_MEMORY_SCOPE_AGENT);
    __syncthreads();
}
__device__ void rwkv_out_slice(const Args& a, int row0, int h);
struct CoopJob { int row0, S, h, dir, i0; const float* startp; };
__device__ void scan_coop(const Args& a, LAS unsigned char* lds, const CoopJob jA, const CoopJob jB, int n) {
    const bf16_t* PR = (const bf16_t*)(a.ws + OFF_PR); const bf16_t* LORA = (const bf16_t*)(a.ws + OFF_LORA);
    bf16_t* Y = (bf16_t*)(a.ws + OFF_Y); float* CB = (float*)(a.ws + OFF_C);
    const int wave = __builtin_amdgcn_readfirstlane(threadIdx.x >> 6), lane = threadIdx.x & 63, c = wave >> 2, rg = wave & 3, qd = lane >> 2, kq = lane & 3;
    const int row0 = c ? jB.row0 : jA.row0, S = c ? jB.S : jA.S, h = c ? jB.h : jA.h, dir = c ? jB.dir : jA.dir, i0 = c ? jB.i0 : jA.i0;
    const float* startp = c ? jB.startp : jA.startp;
    LAS float* buf = (LAS float*)lds + c * (2 * 8 * 384);
    const int ch = h * 64 + lane;
    const float mpr_r = a.in[I_MUP][ch], mnx_r = a.in[I_MUN][ch], mpr_k = a.in[I_MUP][512 + ch], mnx_k = a.in[I_MUN][512 + ch], mpr_v = a.in[I_MUP][1024 + ch], mnx_v = a.in[I_MUN][1024 + ch];
    const float kkc = a.in[I_KK][ch], kac = a.in[I_KA][ch], rkc = a.in[I_RK][ch];
    const float w0c = a.in[I_W0][dir * 512 + ch], a0c = a.in[I_A0][dir * 512 + ch];
    const int myrow = 16 * rg + qd;
    f32x2 St[8];
#pragma unroll
    for (int k2 = 0; k2 < 8; ++k2) St[k2] = startp ? *(const f32x2*)(startp + myrow * 64 + kq * 16 + 2 * k2) : (f32x2){0.f, 0.f};
    const int sd = dir ? -1 : 1, t0 = dir ? S - 1 - i0 : i0;
    bf16_t lr[2][3], lk[2][3], lv[2][3], lw[2], la[2];
    const bf16_t* prp = PR + (size_t)(row0 + t0 + sd * rg) * 1920 + ch;
    const bf16_t* lop = LORA + (size_t)(row0 + t0 + sd * rg) * 2048 + dir * 512 + ch;
    float* cbp = CB + ((size_t)dir * NTOK + row0 + t0 + sd * rg) * 8 + h;
    bf16_t* ypw = Y + ((size_t)dir * NTOK + row0 + t0) * 512 + h * 64 + myrow;
    const long rstep = (long)sd * 1920, lstep = (long)sd * 2048;
#define COOP_LOADS(IB, R_, K_, V_, W_, A_) _Pragma("unroll") for (int e = 0; e < 2; ++e) { const int t = t0 + sd * ((IB) + 4 * e + rg); const bool okp = t > 0, okn = t < S - 1; \
        const bf16_t* p = prp + rstep * ((IB) + 4 * e); \
        R_[e][1] = p[0]; K_[e][1] = p[512]; V_[e][1] = p[1024]; \
        const bf16_t r0_ = p[-1920], k0_ = p[-1920 + 512], v0_ = p[-1920 + 1024], r2_ = p[1920], k2_ = p[1920 + 512], v2_ = p[1920 + 1024]; \
        R_[e][0] = okp ? r0_ : (bf16_t)0; K_[e][0] = okp ? k0_ : (bf16_t)0; V_[e][0] = okp ? v0_ : (bf16_t)0; \
        R_[e][2] = okn ? r2_ : (bf16_t)0; K_[e][2] = okn ? k2_ : (bf16_t)0; V_[e][2] = okn ? v2_ : (bf16_t)0; \
        const bf16_t* lp = lop + lstep * ((IB) + 4 * e); W_[e] = lp[0]; A_[e] = lp[1024]; }
    COOP_LOADS(0, lr, lk, lv, lw, la)
    for (int ib = 0; ib < n; ib += 8) {
        bf16_t nr[2][3], nk[2][3], nv[2][3], nw[2], na[2];
        { const int ibn = (ib + 8 < n) ? ib + 8 : ib; COOP_LOADS(ibn, nr, nk, nv, nw, na) }
        LAS float* bb = buf + ((ib >> 3) & 1) * (8 * 384);
#pragma unroll
        for (int e = 0; e < 2; ++e) {
            const int t = t0 + sd * (ib + 4 * e + rg);
            const float rc = bf2f(lr[e][1]), kc = bf2f(lk[e][1]), vc = bf2f(lv[e][1]);
            const float r = rc + mpr_r * (bf2f(lr[e][0]) - rc) + mnx_r * (bf2f(lr[e][2]) - rc);
            const float k = kc + mpr_k * (bf2f(lk[e][0]) - kc) + mnx_k * (bf2f(lk[e][2]) - kc);
            const float v = vc + mpr_v * (bf2f(lv[e][0]) - vc) + mnx_v * (bf2f(lv[e][2]) - vc);
            const float wraw = bf2f(lw[e]) + w0c, apre = bf2f(la[e]) + a0c;
            const float w = __expf(-0.60653066f * __builtin_amdgcn_rcpf(1.f + __expf(-wraw)));
            const float av = __builtin_amdgcn_rcpf(1.f + __expf(-apre));
            const float kkr = k * kkc; const float ssq = wave_sum(kkr * kkr);
            const float kk = kkr * rsqrtf(fmaxf(ssq, 1e-24f));
            const float kd = k * (1.f + (av - 1.f) * kac);
            const float bq = kk * av;
            const float cd = wave_sum(r * kd * rkc);
            LAS float* o = bb + (4 * e + rg) * 384;
            o[lane] = w; o[64 + lane] = kk; o[128 + lane] = bq; o[192 + lane] = kd; o[256 + lane] = r; o[320 + lane] = v;
            cbp[(long)sd * 8 * (ib + 4 * e)] = cd;
        }
        asm volatile("s_waitcnt lgkmcnt(0)" ::: "memory");
        __builtin_amdgcn_s_barrier();
        asm volatile("" ::: "memory");
        f32x4 vb_[2][20]; float vr_[2];
#define ROW_LOAD(U) { const LAS f32x4* V4 = (const LAS f32x4*)(bb + (U) * 384); \
            _Pragma("unroll") for (int j = 0; j < 4; ++j) { vb_[(U) & 1][j] = V4[16 + kq * 4 + j]; vb_[(U) & 1][4 + j] = V4[kq * 4 + j]; vb_[(U) & 1][8 + j] = V4[32 + kq * 4 + j]; \
                vb_[(U) & 1][12 + j] = V4[48 + kq * 4 + j]; vb_[(U) & 1][16 + j] = V4[64 + kq * 4 + j]; } \
            vr_[(U) & 1] = bb[(U) * 384 + 320 + myrow]; }
        ROW_LOAD(0)
#pragma unroll
        for (int u = 0; u < 8; ++u) {
            if (u < 7) ROW_LOAD(u + 1)
            __builtin_amdgcn_sched_barrier(0);
            const f32x4* cv = vb_[u & 1];
            const float vr = vr_[u & 1];
            const f32x2 vv2 = (f32x2){vr, vr};
            f32x2 a0 = St[0] * (f32x2){cv[0][0], cv[0][1]}, a1 = St[1] * (f32x2){cv[0][2], cv[0][3]};
            f32x2 a2 = St[2] * (f32x2){cv[1][0], cv[1][1]}, a3 = St[3] * (f32x2){cv[1][2], cv[1][3]};
            a0 += St[4] * (f32x2){cv[2][0], cv[2][1]}; a1 += St[5] * (f32x2){cv[2][2], cv[2][3]};
            a2 += St[6] * (f32x2){cv[3][0], cv[3][1]}; a3 += St[7] * (f32x2){cv[3][2], cv[3][3]};
            f32x2 P[8];
#pragma unroll
            for (int j = 0; j < 4; ++j) { const f32x4 w4 = cv[4 + j], d4 = cv[12 + j];
                P[2 * j] = St[2 * j] * (f32x2){w4[0], w4[1]} + vv2 * (f32x2){d4[0], d4[1]};
                P[2 * j + 1] = St[2 * j + 1] * (f32x2){w4[2], w4[3]} + vv2 * (f32x2){d4[2], d4[3]}; }
            const f32x2 as_ = (a0 + a1) + (a2 + a3);
            const float sa = quad_sum(as_[0] + as_[1]);
            const f32x2 nsa = (f32x2){-sa, -sa};
#pragma unroll
            for (int j = 0; j < 4; ++j) { const f32x4 b4 = cv[8 + j];
                St[2 * j] = nsa * (f32x2){b4[0], b4[1]} + P[2 * j]; St[2 * j + 1] = nsa * (f32x2){b4[2], b4[3]} + P[2 * j + 1]; }
            f32x2 y0 = St[0] * (f32x2){cv[16][0], cv[16][1]}, y1 = St[1] * (f32x2){cv[16][2], cv[16][3]};
            f32x2 y2 = St[2] * (f32x2){cv[17][0], cv[17][1]}, y3 = St[3] * (f32x2){cv[17][2], cv[17][3]};
            y0 += St[4] * (f32x2){cv[18][0], cv[18][1]}; y1 += St[5] * (f32x2){cv[18][2], cv[18][3]};
            y2 += St[6] * (f32x2){cv[19][0], cv[19][1]}; y3 += St[7] * (f32x2){cv[19][2], cv[19][3]};
            const f32x2 ys_ = (y0 + y1) + (y2 + y3);
            const float y = quad_sum(ys_[0] + ys_[1]);
            ypw[(long)sd * 512 * (ib + u)] = (bf16_t)cvt_pk_bf16(y, y);
        }
#undef ROW_LOAD
#pragma unroll
        for (int e = 0; e < 2; ++e) {
#pragma unroll
            for (int q = 0; q < 3; ++q) { lr[e][q] = nr[e][q]; lk[e][q] = nk[e][q]; lv[e][q] = nv[e][q]; }
            lw[e] = nw[e]; la[e] = na[e]; }
    }
#undef COOP_LOADS
    __syncthreads();
}
__device__ void phase_scan_main(const Args& a, LAS unsigned char* lds, bool comb) {
    if (comb) for (int cj = blockIdx.x; cj < 64; cj += gridDim.x) combine_chain(a, lds, cj >> 2, cj & 3);
    for (int j = blockIdx.x; j < 256; j += gridDim.x) { const int sq = j >> 3, h = j & 7;
        CoopJob A; A.row0 = NP + sq * SS; A.S = SS; A.h = h; A.dir = 0; A.i0 = 0; A.startp = nullptr; CoopJob B = A; B.dir = 1;
        scan_coop(a, lds, A, B, SS);
        __threadfence(); __syncthreads();
        rwkv_out_slice(a, A.row0, h); }
    for (int pj = blockIdx.x; pj < 8 * NSEGP; pj += gridDim.x) { const int id = 2 * pj, chain = id / NSEGP, seg = id % NSEGP;
        const int* fl = (const int*)(a.ws + OFF_FLAG) + chain;
        while (__hip_atomic_load(fl, __ATOMIC_ACQUIRE, __HIP_MEMORY_SCOPE_AGENT) < 4) __builtin_amdgcn_s_sleep(8);
        CoopJob A; A.row0 = 0; A.S = NP; A.h = chain >> 1; A.dir = chain & 1; A.i0 = seg * SEG; A.startp = seg ? sum_slot(a, chain, seg - 1, 1) : nullptr;
        CoopJob B = A; B.i0 = (seg + 1) * SEG; B.startp = sum_slot(a, chain, seg, 1);
        scan_coop(a, lds, A, B, SEG); }
}

struct RwkvOutConst { float mp[8], mn[8], lw[8], lb[8]; };
__device__ __forceinline__ void rwkv_out_load_const(const Args& a, int ch, RwkvOutConst& c) {
#pragma unroll
    for (int j = 0; j < 8; ++j) { c.mp[j] = a.in[I_MUP][1024 + ch + j]; c.mn[j] = a.in[I_MUN][1024 + ch + j]; c.lw[j] = a.in[I_LNW][ch + j]; c.lb[j] = a.in[I_LNB][ch + j]; }
}
__device__ __forceinline__ void rwkv_out_item(const Args& a, int row, int ch, int h, const RwkvOutConst& c) {
    const bf16_t* PR = (const bf16_t*)(a.ws + OFF_PR); const bf16_t* Y = (const bf16_t*)(a.ws + OFF_Y); const float* CB = (const float*)(a.ws + OFF_C);
    const bf16_t* G = (const bf16_t*)((const unsigned char*)a.out + OUT_OFF_G); bf16_t* MIX = (bf16_t*)(a.ws + OFF_H);
    int pos, S; if (row < NP) { pos = row; S = NP; } else { pos = (row - NP) % SS; S = SS; }
    const bool hp = pos > 0, hn = pos < S - 1;
    const u32x4 yf = *(const u32x4*)(Y + (size_t)row * 512 + ch), yb = *(const u32x4*)(Y + ((size_t)NTOK + row) * 512 + ch);
    const u32x4 gg = *(const u32x4*)(G + (size_t)row * 512 + ch);
    const bf16_t* vp = PR + (size_t)row * 1920 + 1024 + ch;
    const u32x4 vc = *(const u32x4*)vp;
    const u32x4 vpv = hp ? *(const u32x4*)(vp - 1920) : (u32x4){0u, 0u, 0u, 0u};
    const u32x4 vnx = hn ? *(const u32x4*)(vp + 1920) : (u32x4){0u, 0u, 0u, 0u};
    const float cs = CB[(size_t)row * 8 + h] + CB[((size_t)NTOK + row) * 8 + h];
    float y[8], gv[8], vs[8];
#pragma unroll
    for (int j = 0; j < 4; ++j) {
        y[2 * j] = lo_bf(yf[j]) + lo_bf(yb[j]); y[2 * j + 1] = hi_bf(yf[j]) + hi_bf(yb[j]);
        gv[2 * j] = lo_bf(gg[j]); gv[2 * j + 1] = hi_bf(gg[j]);
        const float c0 = lo_bf(vc[j]), c1 = hi_bf(vc[j]);
        vs[2 * j] = c0 + c.mp[2 * j] * (lo_bf(vpv[j]) - c0) + c.mn[2 * j] * (lo_bf(vnx[j]) - c0);
        vs[2 * j + 1] = c1 + c.mp[2 * j + 1] * (hi_bf(vpv[j]) - c1) + c.mn[2 * j + 1] * (hi_bf(vnx[j]) - c1);
    }
    float s = 0.f;
#pragma unroll
    for (int j = 0; j < 8; ++j) s += y[j];
    s += __shfl_xor(s, 1); s += __shfl_xor(s, 2); s += __shfl_xor(s, 4);
    const float mu = s * (1.f / 64.f);
    float q = 0.f;
#pragma unroll
    for (int j = 0; j < 8; ++j) { const float dlt = y[j] - mu; q += dlt * dlt; }
    q += __shfl_xor(q, 1); q += __shfl_xor(q, 2); q += __shfl_xor(q, 4);
    const float rs = rsqrtf(q * (1.f / 64.f) + LNX_EPS);
    float o[8];
#pragma unroll
    for (int j = 0; j < 8; ++j) o[j] = ((y[j] - mu) * rs * c.lw[j] + c.lb[j] + cs * vs[j]) * gv[j];
    u32x4 w; w.x = cvt_pk_bf16(o[0], o[1]); w.y = cvt_pk_bf16(o[2], o[3]); w.z = cvt_pk_bf16(o[4], o[5]); w.w = cvt_pk_bf16(o[6], o[7]);
    *(u32x4*)(MIX + (size_t)row * DM + 512 + ch) = w;
}
__device__ void phase_rwkv_out(const Args& a) {
    const int wave = threadIdx.x >> 6, lane = threadIdx.x & 63, ch = lane * 8, h = lane >> 3;
    RwkvOutConst c; rwkv_out_load_const(a, ch, c);
    for (int row = blockIdx.x * 8 + wave; row < NP; row += gridDim.x * 8) rwkv_out_item(a, row, ch, h, c);
}
__device__ void rwkv_out_slice(const Args& a, int row0, int h) {
    const int wave = threadIdx.x >> 6, lane = threadIdx.x & 63, ch = h * 64 + (lane & 7) * 8;
    RwkvOutConst c; rwkv_out_load_const(a, ch, c);
    for (int r = wave * 8 + (lane >> 3); r < SS; r += 64) rwkv_out_item(a, row0 + r, ch, h, c);
}

#define XB_TMO      128
#define XB_XCNT(j)  (256  + 64 * (j))
#define XB_XSUB(j)  (1280 + 64 * (j))
#define XB_XGEN(j)  (2304 + 64 * (j))
#define XB_TOP      3328
#define XB_TOPGEN   3392
#define XCD_BAR_WORDS 3456
#define XB_SPIN_CAP (1u << 18)
__device__ __forceinline__ unsigned xb_ld(unsigned* p)              { return __hip_atomic_load(p, __ATOMIC_RELAXED, __HIP_MEMORY_SCOPE_AGENT); }
__device__ __forceinline__ unsigned xb_add(unsigned* p, unsigned v) { return __hip_atomic_fetch_add(p, v, __ATOMIC_RELAXED, __HIP_MEMORY_SCOPE_AGENT); }
__device__ __forceinline__ unsigned xb_xcc_id() { return (unsigned)__builtin_amdgcn_s_getreg((3 << 11) | 20) & 0xFu; }
#define XB_SPIN(cond, bar) do { unsigned _sp = 0; while (cond) { __builtin_amdgcn_s_sleep(1); \
    if ((++_sp & 255u) == 0u) { if (xb_ld(&(bar)[XB_TMO])) break; if (_sp > XB_SPIN_CAP) { atomicAdd(&(bar)[XB_TMO], 1u); break; } } } } while (0)
struct XcdBarrier { unsigned* bar; unsigned x; volatile LAS unsigned* st; };
__device__ __forceinline__ XcdBarrier xcd_barrier_post(unsigned* bar, volatile LAS unsigned* st) {
    XcdBarrier b; b.bar = bar; b.x = xb_xcc_id(); b.st = st;
    if (threadIdx.x == 0) (void)xb_add(&bar[XB_XCNT(b.x)], 1u);
    return b;
}
__device__ __forceinline__ void xcd_barrier_complete(unsigned* bar, unsigned x, unsigned& nloc, unsigned& nx) {
    const unsigned G = gridDim.x * gridDim.y * gridDim.z;
    unsigned sum, cnt, mine, sp = 0u;
    for (;;) {
        sum = 0u; cnt = 0u; mine = 0u;
#pragma unroll
        for (unsigned j = 0; j < 16; ++j) { const unsigned c = xb_ld(&bar[XB_XCNT(j)]); sum += c; cnt += (c > 0u) ? 1u : 0u; mine = (j == x) ? c : mine; }
        if (sum == G) break;
        __builtin_amdgcn_s_sleep(1);
        if ((++sp & 255u) == 0u) { if (xb_ld(&bar[XB_TMO])) break; if (sp > XB_SPIN_CAP) { atomicAdd(&bar[XB_TMO], 1u); break; } }
    }
    nloc = mine > 0u ? mine : 1u; nx = cnt > 0u ? cnt : 1u;
}
__device__ __forceinline__ void xcd_barrier(const XcdBarrier& b) {
    asm volatile("s_waitcnt vmcnt(0)" ::: "memory");
    __syncthreads();
    if (threadIdx.x == 0) {
        unsigned* bar = b.bar;
        __builtin_amdgcn_s_waitcnt(0);
        unsigned nloc = b.st[0], nx = b.st[1];
        if (nloc == 0u) { xcd_barrier_complete(bar, b.x, nloc, nx); b.st[0] = nloc; b.st[1] = nx; }
        const unsigned old = xb_add(&bar[XB_XSUB(b.x)], 1u);
        const unsigned gen = old / nloc;
        if (old + 1u == (gen + 1u) * nloc) {
            __builtin_amdgcn_fence(__ATOMIC_RELEASE, "agent");
            asm volatile("s_waitcnt vmcnt(0)" ::: "memory");
            const unsigned og = xb_add(&bar[XB_TOP], 1u);
            const unsigned tg = og / nx;
            if (og + 1u == (tg + 1u) * nx) xb_add(&bar[XB_TOPGEN], 1u);
            else XB_SPIN(xb_ld(&bar[XB_TOPGEN]) == tg, bar);
            __builtin_amdgcn_fence(__ATOMIC_ACQUIRE, "agent");
            xb_add(&bar[XB_XGEN(b.x)], 1u);
            asm volatile("s_waitcnt vmcnt(0)" ::: "memory");
        } else {
            XB_SPIN(xb_ld(&bar[XB_XGEN(b.x)]) == gen, bar);
            __builtin_amdgcn_fence(__ATOMIC_ACQUIRE, "agent");
            asm volatile("s_waitcnt vmcnt(0)" ::: "memory");
        }
    }
    __syncthreads();
}

template <class Epi>
__device__ __forceinline__ void run_gemm(LAS unsigned char* lds, const bf16_t* A, const bf16_t* Bt, int N, int K, const Epi& E) {
    pg8::Gemm g; g.A = A; g.Bt = Bt; g.M = NTOK; g.N = N; g.K = K;
    pg8::StaticOrder S; S.init(NTOK, N, (int)gridDim.x, (int)blockIdx.x);
    pg8::gemm_phase<Epi>(lds, g, S, E);
}

__global__ void __launch_bounds__(512, 2) mega(Args a) {
    extern __shared__ __attribute__((aligned(16))) unsigned char shm[];
    LAS unsigned char* lds = (LAS unsigned char*)shm;
    cg::grid_group grid = cg::this_grid();
    volatile LAS unsigned* xst = (volatile LAS unsigned*)(lds + 131072);
    if (threadIdx.x == 0) { xst[0] = 0u; xst[1] = 0u; }
    __syncthreads();
    const XcdBarrier xb = xcd_barrier_post((unsigned*)(a.ws + OFF_BAR), xst);
#ifndef PHMASK
#define PHMASK 0xFFF
#endif
#ifndef DUP
#define DUP 0
#endif
#define PHASE(k, body) if (a.ph_lo <= (k) && (k) < a.ph_hi) { if ((k) != a.ph_lo) { if ((k) == 1) grid.sync(); else xcd_barrier(xb); } if constexpr ((PHMASK >> (k)) & 1) { body } }
    PHASE(0, phase_prep_weights(a, lds); phase_mod(a, lds); if (DUP & 8) { phase_prep_weights(a, lds); phase_mod(a, lds); })
    PHASE(1, phase_norm(a, a.in[I_XP], a.in[I_XS], a.in[I_G1], 0, 1024); if (DUP & 32) phase_norm(a, a.in[I_XP], a.in[I_XS], a.in[I_G1], 0, 1024);)
    PHASE(2, EpiIn E; E.QKV = (bf16_t*)a.out; E.PR = (bf16_t*)(a.ws + OFF_PR); E.qg = a.in[I_QG]; E.kg = a.in[I_KG];
             run_gemm(lds, (const bf16_t*)(a.ws + OFF_H), (const bf16_t*)(a.ws + OFF_WIN), NINP, 1024, E); if (DUP & 16) run_gemm(lds, (const bf16_t*)(a.ws + OFF_H), (const bf16_t*)(a.ws + OFF_WIN), NINP, 1024, E);)
    PHASE(3, phase_post_in(a); if (DUP & 64) { for (int q = 0; q < 10; ++q) grid.sync(); })
    PHASE(4, EpiLora E; E.LORA = (bf16_t*)(a.ws + OFF_LORA); E.G = (bf16_t*)((unsigned char*)a.out + OUT_OFF_G); E.w0 = a.in[I_W0]; E.a0 = a.in[I_A0];
             run_gemm(lds, (const bf16_t*)(a.ws + OFF_X5), (const bf16_t*)(a.ws + OFF_WL), 2560, 384, E);)
    PHASE(5, phase_attn(a, lds); if (DUP & 1) phase_attn(a, lds); phase_scan_pass1(a, lds); if (DUP & 4) phase_scan_pass1(a, lds);)
    PHASE(6, phase_scan_main(a, lds, true); if (DUP & 2) phase_scan_main(a, lds, false);)
    PHASE(7, phase_rwkv_out(a); if (DUP & 32) phase_rwkv_out(a);)
    PHASE(8, EpiRes E; E.out = a.out; E.xp = a.in[I_XP]; E.xs = a.in[I_XS]; E.mod = (const float*)(a.ws + OFF_MOD); E.gate_off = 2048;
             run_gemm(lds, (const bf16_t*)(a.ws + OFF_H), (const bf16_t*)(a.ws + OFF_WOUT), 1024, 1024, E);)
    PHASE(9, phase_norm(a, a.out, a.out + (size_t)NP * DM, a.in[I_G2], 3072, 4096);)
    PHASE(10, EpiFf1 E; E.HID = (bf16_t*)(a.ws + OFF_HID);
             run_gemm(lds, (const bf16_t*)(a.ws + OFF_H), (const bf16_t*)(a.ws + OFF_WFF1), DFF, 1024, E); if (DUP & 16) run_gemm(lds, (const bf16_t*)(a.ws + OFF_H), (const bf16_t*)(a.ws + OFF_WFF1), DFF, 1024, E);)
    PHASE(11, EpiRes E; E.out = a.out; E.xp = nullptr; E.xs = nullptr; E.mod = (const float*)(a.ws + OFF_MOD); E.gate_off = 5120;
             run_gemm(lds, (const bf16_t*)(a.ws + OFF_HID), (const bf16_t*)(a.ws + OFF_WFF2), 1024, DFF, E);)
}

#ifndef N_LAUNCHES
#define N_LAUNCHES 1
#endif

extern "C" void kernel_launch(void* const* d_in, const int* in_sizes, int n_in, void* d_out, int out_size, void* d_ws, size_t ws_size, hipStream_t stream) {
    static int grid = 0;
    if (grid == 0) {
        if (n_in != 27 || out_size != NTOK * DM || ws_size < WS_END) { fprintf(stderr, "kernel_launch: unexpected shapes (n_in %d out %d ws %zu need %zu)\n", n_in, out_size, ws_size, (size_t)WS_END); grid = -1; return; }
        int dev = 0, cus = 0, per_cu = 0;
        hipGetDevice(&dev);
        hipDeviceGetAttribute(&cus, hipDeviceAttributeMultiprocessorCount, dev);
        hipFuncSetAttribute((const void*)mega, hipFuncAttributeMaxDynamicSharedMemorySize, LDS_BYTES);
        hipOccupancyMaxActiveBlocksPerMultiprocessor(&per_cu, (const void*)mega, 512, LDS_BYTES);
        if (per_cu < 1) { fprintf(stderr, "kernel_launch: occupancy query says %d blocks/CU\n", per_cu); per_cu = 1; }
        grid = cus * per_cu;
        (void)hipGetLastError();
    }
    if (grid < 0) return;
    if (hipMemsetAsync((char*)d_ws + OFF_BAR, 0, BAR_BYTES, stream) != hipSuccess) { fprintf(stderr, "kernel_launch: memset of the barrier words failed\n"); return; }
    Args a{};
    for (int i = 0; i < 27; ++i) a.in[i] = (const float*)d_in[i];
    a.out = (float*)d_out; a.ws = (unsigned char*)d_ws;
    if (N_LAUNCHES == 1) {
        a.ph_lo = 0; a.ph_hi = NPH;
        void* args[] = {&a};
        hipError_t e = hipLaunchCooperativeKernel((const void*)mega, dim3(grid), dim3(512), args, LDS_BYTES, stream);
        if (e != hipSuccess) fprintf(stderr, "cooperative launch failed: %s (grid %d)\n", hipGetErrorString(e), grid);
    } else {
        for (int ph = 0; ph < NPH; ++ph) {
            a.ph_lo = ph; a.ph_hi = ph + 1;
            void* args[] = {&a};
            hipError_t e = hipLaunchCooperativeKernel((const void*)mega, dim3(grid), dim3(512), args, LDS_BYTES, stream);
            if (e != hipSuccess) fprintf(stderr, "cooperative launch failed: %s (grid %d)\n", hipGetErrorString(e), grid);
        }
    }
}
```

```cpp
#include <hip/hip_runtime.h>
#include <hip/hip_cooperative_groups.h>
#include <cstdio>
namespace cg = cooperative_groups;

#define LAS __attribute__((address_space(3)))
typedef unsigned short bf16_t;
typedef short bf16x8 __attribute__((ext_vector_type(8)));
typedef float f32x4 __attribute__((ext_vector_type(4)));
typedef float f32x2 __attribute__((ext_vector_type(2)));
typedef unsigned u32x4 __attribute__((ext_vector_type(4)));
typedef unsigned u32x2 __attribute__((ext_vector_type(2)));

constexpr int NTOK = 81920, NP = 16384, SS = 2048, DM = 1024, NSEQ = 33;
constexpr int NIN = 3456, NINP = 3584, DFF = 4096;
constexpr float NORM_EPS = 1e-6f, LNX_EPS = 64e-5f;
constexpr int LDS_BYTES = 131072 + 16;
constexpr int NPH = 12;

constexpr size_t OFF_WIN = 0;
constexpr size_t OFF_WOUT = OFF_WIN + (size_t)NINP * 1024 * 2;
constexpr size_t OFF_WFF1 = OFF_WOUT + (size_t)1024 * 1024 * 2;
constexpr size_t OFF_WFF2 = OFF_WFF1 + (size_t)4096 * 1024 * 2;
constexpr size_t OFF_WL = OFF_WFF2 + (size_t)1024 * 4096 * 2;
constexpr size_t OFF_MOD = OFF_WL + (size_t)2560 * 384 * 2;
constexpr size_t OFF_C = OFF_MOD + (size_t)NSEQ * 6144 * 4;
constexpr size_t OFF_H = OFF_C + (size_t)2 * NTOK * 8 * 4;
constexpr size_t OFF_PR = OFF_H + (size_t)NTOK * 1024 * 2;
constexpr size_t OFF_LORA = OFF_PR + (size_t)NTOK * 1920 * 2;
constexpr size_t OFF_Y = OFF_LORA + (size_t)NTOK * 2048 * 2;
constexpr size_t OFF_SUM = OFF_Y + (size_t)NTOK * 1024 * 2;
constexpr size_t OFF_FLAG = OFF_SUM + (size_t)16 * 64 * 32768;
constexpr size_t OFF_BAR = OFF_FLAG + 256;
constexpr size_t BAR_BYTES = 3456 * 4;
constexpr size_t WS_END = OFF_BAR + 16384;
constexpr size_t OFF_X5 = OFF_Y;
constexpr size_t OFF_HID = OFF_PR;
static_assert(OFF_HID + (size_t)NTOK * 4096 * 2 <= WS_END, "hid fits");
constexpr size_t OUT_OFF_G = (size_t)NTOK * 1536 * 2;

struct Args {
    const float* in[27];
    float* out;
    unsigned char* ws;
    int ph_lo, ph_hi;
};
enum { I_XP = 0, I_XS, I_CP, I_CS, I_WADA, I_BADA, I_G1, I_G2, I_WIN, I_QG, I_KG, I_BETA, I_MUP, I_MUN, I_W0, I_WUP, I_A0, I_AUP, I_GUP, I_KK, I_KA, I_RK, I_LNW, I_LNB, I_WOUT, I_WFF1, I_WFF2 };

__device__ __forceinline__ float bf2f(bf16_t b) { return __uint_as_float(((unsigned)b) << 16); }
__device__ __forceinline__ bf16_t f2bf(float f) { unsigned u = __float_as_uint(f); u += 0x7FFFu + ((u >> 16) & 1u); return (bf16_t)(u >> 16); }
__device__ __forceinline__ unsigned cvt_pk_bf16(float lo, float hi) { unsigned r; asm volatile("v_cvt_pk_bf16_f32 %0, %1, %2" : "=v"(r) : "v"(lo), "v"(hi)); return r; }
__device__ __forceinline__ float lo_bf(unsigned u) { return __uint_as_float(u << 16); }
__device__ __forceinline__ float hi_bf(unsigned u) { return __uint_as_float(u & 0xffff0000u); }
template <int CTRL> __device__ __forceinline__ float dpp_mov(float x) { return __int_as_float(__builtin_amdgcn_update_dpp(0, __float_as_int(x), CTRL, 0xF, 0xF, true)); }
__device__ __forceinline__ float wave_sum(float v) {
    v += dpp_mov<0xB1>(v); v += dpp_mov<0x4E>(v); v += dpp_mov<0x141>(v); v += dpp_mov<0x140>(v);
    const float s0 = __int_as_float(__builtin_amdgcn_readlane(__float_as_int(v), 0)), s1 = __int_as_float(__builtin_amdgcn_readlane(__float_as_int(v), 16));
    const float s2 = __int_as_float(__builtin_amdgcn_readlane(__float_as_int(v), 32)), s3 = __int_as_float(__builtin_amdgcn_readlane(__float_as_int(v), 48));
    return (s0 + s1) + (s2 + s3);
}
__device__ __forceinline__ float wave_max(float v) {
#pragma unroll
    for (int o = 32; o >= 1; o >>= 1) v = fmaxf(v, __shfl_xor(v, o));
    return v;
}
__device__ __forceinline__ int seq_of_row(int row) { return row < NP ? 0 : 1 + (row - NP) / SS; }

namespace pg8 {
constexpr int BM = 256, BK = 64, HALF = 128, HTB = HALF * BK * 2, STAGE_BYTES = 8 * HTB, NXCD = 8, WGM = 8;
__device__ __forceinline__ int lds_byte(int r, int c) { const int st = (r >> 4) * 2 + (c >> 5), rr = r & 15, cc = c & 31, ob = rr * 64 + cc * 2; return st * 1024 + (ob ^ (((ob >> 9) & 1) << 5)); }
__device__ __forceinline__ void stage_rc(int b, int& R, int& C) { const int st = b / 1024, sb = b % 1024, swz = sb ^ (((sb >> 9) & 1) << 5); R = (st >> 1) * 16 + swz / 64; C = (st & 1) * 32 + (swz % 64) / 2; }
__device__ __forceinline__ int perm32(int rho) { const int n = rho >> 4, i = rho & 15; return 8 * (i >> 2) + 4 * n + (i & 3); }
struct Unit { int pm, pn; };
struct Gemm { const bf16_t* A; const bf16_t* Bt; int M, N, K; };
struct StaticOrder {
    int nM, nN, nwg, G, c;
    __device__ void init(int M, int N, int G_, int c_) { nM = M / BM; nN = N / BM; nwg = nM * nN; G = G_; c = c_; }
    __device__ bool next(int i, Unit& u) const {
        const long L = (long)i * G + c; if (L >= nwg) return false;
        int wgid = (int)L; { const int q = nwg / NXCD, r = nwg % NXCD, xcd = wgid % NXCD, off = wgid / NXCD; wgid = (xcd < r ? xcd * (q + 1) : r * (q + 1) + (xcd - r) * q) + off; }
        const int nig = WGM * nN, gid = wgid / nig, fm = gid * WGM, gsz = (nM - fm) < WGM ? (nM - fm) : WGM;
        u.pm = fm + ((wgid % nig) % gsz); u.pn = (wgid % nig) / gsz; return true;
    }
};

template <class Epi>
__device__ __forceinline__ void gemm_phase(LAS unsigned char* lds, const Gemm g, const StaticOrder& S, const Epi& E) {
    const int tid = threadIdx.x, wid = __builtin_amdgcn_readfirstlane(tid >> 6), lane = tid & 63, wr = wid >> 2, wc = wid & 3, fr = lane & 15, fq = lane >> 4;
    const int K = g.K, nt = K / BK;
    unsigned voffA[2], voffB[2];
#pragma unroll
    for (int i = 0; i < 2; ++i) { int R, C; stage_rc(tid * 16 + i * 8192, R, C); const int Rb = Epi::PERM ? ((R & ~31) + perm32(R & 31)) : R;
        const int Rh = 64 * (R >> 5) + perm32(R & 31);
        voffA[i] = (unsigned)(R * K + C) * 2u; voffB[i] = (unsigned)((Epi::HEADMAP ? Rh : Rb) * K + C) * 2u; }
    const size_t kstep = (size_t)(BK * 2);
    const size_t hstep = (size_t)HALF * K * 2;
    const size_t tstep = 2 * hstep;
    const size_t hstepB = Epi::HEADMAP ? (size_t)32 * K * 2 : hstep;
    const unsigned ldsw = (unsigned)wid * 1024u;
    const int aoff = lds_byte(wr * 64 + fr, fq * 8), boff = lds_byte(wc * 32 + fr, fq * 8);
#define PG8_SA(b, h) (((b) * 2 + (h)) * HTB)
#define PG8_SB(b, h) ((4 + (b) * 2 + (h)) * HTB)
#define PG8_STAGE(bufoff, gbase, voff) do { _Pragma("unroll") for (int _i = 0; _i < 2; ++_i) \
        __builtin_amdgcn_global_load_lds((const unsigned*)((const char*)(gbase) + (voff)[_i]), (LAS unsigned*)(lds + (bufoff) + ldsw + _i * 8192), 16, 0, 0); } while (0)
#define PG8_LDA(dst, b, h) do { _Pragma("unroll") for (int m = 0; m < 4; ++m) _Pragma("unroll") for (int k = 0; k < 2; ++k) dst[m][k] = *(const LAS bf16x8*)(lds + PG8_SA(b, h) + aoff + m * 2048 + k * 1024); } while (0)
#define PG8_LDB(dst, b, h) do { _Pragma("unroll") for (int n = 0; n < 2; ++n) _Pragma("unroll") for (int k = 0; k < 2; ++k) dst[n][k] = *(const LAS bf16x8*)(lds + PG8_SB(b, h) + boff + n * 2048 + k * 1024); } while (0)
#define PG8_MMA(ai, bj, At, Bt) do { __builtin_amdgcn_s_setprio(1); _Pragma("unroll") for (int m = 0; m < 4; ++m) _Pragma("unroll") for (int n = 0; n < 2; ++n) _Pragma("unroll") for (int k = 0; k < 2; ++k) \
        acc[ai][bj][m][n] = __builtin_amdgcn_mfma_f32_16x16x32_bf16(Bt[n][k], At[m][k], acc[ai][bj][m][n], 0, 0, 0); __builtin_amdgcn_s_setprio(0); } while (0)
#define PG8_WAIT_V(n) asm volatile("s_waitcnt vmcnt(" #n ")" ::: "memory")
#define PG8_WAIT_L(n) asm volatile("s_waitcnt lgkmcnt(" #n ")" ::: "memory")
#define PG8_BAR __builtin_amdgcn_s_barrier()
#define PG8_SCHED __builtin_amdgcn_sched_barrier(0)
    Unit cur, nxt; int ui = 0;
    if (!S.next(0, cur)) return;
    f32x4 acc[2][2][4][2];
#pragma unroll
    for (int a = 0; a < 2; ++a)
#pragma unroll
        for (int b = 0; b < 2; ++b)
#pragma unroll
            for (int m = 0; m < 4; ++m)
#pragma unroll
                for (int n = 0; n < 2; ++n) acc[a][b][m][n] = (f32x4){0.f, 0.f, 0.f, 0.f};
    bf16x8 At[4][2], B0[2][2], B1[2][2];
    const char* cA = (const char*)g.A + (size_t)cur.pm * tstep; const char* cB = (const char*)g.Bt + (size_t)cur.pn * tstep;
    PG8_STAGE(PG8_SB(0, 0), cB, voffB); PG8_STAGE(PG8_SA(0, 0), cA, voffA); PG8_STAGE(PG8_SB(0, 1), cB + hstepB, voffB); PG8_STAGE(PG8_SA(0, 1), cA + hstep, voffA);
    if (wr == 1) PG8_BAR;
    PG8_WAIT_V(4); PG8_BAR;
    PG8_STAGE(PG8_SB(1, 0), cB + kstep, voffB); PG8_STAGE(PG8_SA(1, 0), cA + kstep, voffA); PG8_STAGE(PG8_SB(1, 1), cB + hstepB + kstep, voffB);
    PG8_WAIT_V(6); PG8_BAR;
    for (;;) {
        const bool has_next = S.next(ui + 1, nxt);
        const char* nA = has_next ? (const char*)g.A + (size_t)nxt.pm * tstep : cA; const char* nB = has_next ? (const char*)g.Bt + (size_t)nxt.pn * tstep : cB;
#pragma unroll 1
        for (int t = 0; t < nt; t += 2) {
            const bool last = (t == nt - 2);
            const char* a1 = cA + (size_t)(t + 1) * kstep;
            const char* a2 = last ? nA : cA + (size_t)(t + 2) * kstep; const char* b2 = last ? nB : cB + (size_t)(t + 2) * kstep;
            const char* a3 = a2 + kstep; const char* b3 = b2 + kstep;
            PG8_LDB(B0, 0, 0); PG8_SCHED; PG8_LDA(At, 0, 0); PG8_STAGE(PG8_SA(1, 1), a1 + hstep, voffA);
            PG8_WAIT_L(8); PG8_BAR; PG8_WAIT_L(0); PG8_MMA(0, 0, At, B0); PG8_BAR; PG8_SCHED;
            PG8_LDB(B1, 0, 1); PG8_STAGE(PG8_SB(0, 0), b2, voffB);
            PG8_BAR; PG8_WAIT_L(0); PG8_MMA(0, 1, At, B1); PG8_BAR;
            PG8_LDA(At, 0, 1); PG8_STAGE(PG8_SA(0, 0), a2, voffA);
            PG8_BAR; PG8_WAIT_L(0); PG8_MMA(1, 0, At, B0); PG8_BAR; PG8_SCHED;
            PG8_STAGE(PG8_SB(0, 1), b2 + hstepB, voffB);
            PG8_WAIT_V(6); PG8_BAR; PG8_MMA(1, 1, At, B1); PG8_BAR;
            PG8_LDB(B0, 1, 0); PG8_SCHED; PG8_LDA(At, 1, 0); PG8_STAGE(PG8_SA(0, 1), a2 + hstep, voffA);
            PG8_WAIT_L(8); PG8_BAR; PG8_WAIT_L(0); PG8_MMA(0, 0, At, B0); PG8_BAR; PG8_SCHED;
            PG8_LDB(B1, 1, 1); PG8_STAGE(PG8_SB(1, 0), b3, voffB);
            PG8_BAR; PG8_WAIT_L(0); PG8_MMA(0, 1, At, B1); PG8_BAR;
            PG8_LDA(At, 1, 1); PG8_STAGE(PG8_SA(1, 0), a3, voffA);
            PG8_BAR; PG8_WAIT_L(0); PG8_MMA(1, 0, At, B0); PG8_BAR; PG8_SCHED;
            PG8_STAGE(PG8_SB(1, 1), b3 + hstepB, voffB);
            PG8_WAIT_V(6); PG8_BAR; PG8_MMA(1, 1, At, B1); PG8_BAR;
        }
        E(acc, cur, wr, wc, fr, fq);
        if (!has_next) break;
#pragma unroll
        for (int a = 0; a < 2; ++a)
#pragma unroll
            for (int b = 0; b < 2; ++b)
#pragma unroll
                for (int m = 0; m < 4; ++m)
#pragma unroll
                    for (int n = 0; n < 2; ++n) acc[a][b][m][n] = (f32x4){0.f, 0.f, 0.f, 0.f};
        cur = nxt; cA = nA; cB = nB; ++ui;
    }
    PG8_WAIT_V(0);
    if (wr == 0) PG8_BAR;
    PG8_BAR;
#undef PG8_SA
#undef PG8_SB
#undef PG8_STAGE
#undef PG8_LDA
#undef PG8_LDB
#undef PG8_MMA
#undef PG8_WAIT_V
#undef PG8_WAIT_L
#undef PG8_BAR
#undef PG8_SCHED
}
}
using pg8::Unit;
typedef f32x4 AccT[2][2][4][2];

struct EpiIn {
    static constexpr bool PERM = true, HEADMAP = true;
    bf16_t* QKV; bf16_t* PR; const float* qg; const float* kg;
    __device__ __forceinline__ void operator()(const AccT& acc, const Unit& u, int wr, int wc, int fr, int fq) const {
        const int row0 = u.pm * 256 + wr * 64 + fr;
        bf16_t* base; int ldc, colt, lim;
        if (u.pn < 6) { base = QKV; ldc = 1536; colt = u.pn * 256; lim = 1536; } else { base = PR; ldc = 1920; colt = (u.pn - 6) * 256; lim = 1920; }
        const int col0 = colt + wc * 64 + 8 * fq;
        const bool nrm = u.pn < 4;
        f32x4 g4[2][2];
        if (nrm) { const float* gp = (u.pn < 2 ? qg : kg) + 8 * fq;
#pragma unroll
            for (int bj = 0; bj < 2; ++bj)
#pragma unroll
                for (int n = 0; n < 2; ++n) g4[bj][n] = *(const f32x4*)(gp + 32 * bj + 4 * n); }
        const float qs = u.pn < 2 ? 0.125f : 1.f;
#pragma unroll
        for (int ai = 0; ai < 2; ++ai)
#pragma unroll
            for (int m = 0; m < 4; ++m) { bf16_t* rowp = base + (size_t)(row0 + ai * 128 + m * 16) * ldc + col0;
                f32x4 v[2][2];
#pragma unroll
                for (int bj = 0; bj < 2; ++bj)
#pragma unroll
                    for (int n = 0; n < 2; ++n) v[bj][n] = acc[ai][bj][m][n];
                if (nrm) {
                    float ss = 0.f;
#pragma unroll
                    for (int bj = 0; bj < 2; ++bj)
#pragma unroll
                        for (int n = 0; n < 2; ++n) ss += v[bj][n][0] * v[bj][n][0] + v[bj][n][1] * v[bj][n][1] + v[bj][n][2] * v[bj][n][2] + v[bj][n][3] * v[bj][n][3];
                    ss += __shfl_xor(ss, 16); ss += __shfl_xor(ss, 32);
                    const float sc = rsqrtf(ss * (1.f / 64.f) + NORM_EPS) * qs;
#pragma unroll
                    for (int bj = 0; bj < 2; ++bj)
#pragma unroll
                        for (int n = 0; n < 2; ++n) v[bj][n] = v[bj][n] * sc * g4[bj][n];
                }
#pragma unroll
                for (int bj = 0; bj < 2; ++bj) {
                    u32x4 w; w.x = cvt_pk_bf16(v[bj][0][0], v[bj][0][1]); w.y = cvt_pk_bf16(v[bj][0][2], v[bj][0][3]); w.z = cvt_pk_bf16(v[bj][1][0], v[bj][1][1]); w.w = cvt_pk_bf16(v[bj][1][2], v[bj][1][3]);
                    if (col0 + bj * 32 < lim) *(u32x4*)(rowp + bj * 32) = w; } }
    }
};
struct EpiLora {
    static constexpr bool PERM = true, HEADMAP = false;
    bf16_t* LORA; bf16_t* G; const float* w0; const float* a0;
    __device__ __forceinline__ void operator()(const AccT& acc, const Unit& u, int wr, int wc, int fr, int fq) const {
        const int row0 = u.pm * 256 + wr * 64 + fr;
        bf16_t* base; int ldc, colt; const bool isg = u.pn >= 8;
        if (!isg) { base = LORA; ldc = 2048; colt = u.pn * 256; } else { base = G; ldc = 512; colt = (u.pn - 8) * 256; }
        const int col0 = colt + wc * 32 + 8 * fq;
#pragma unroll
        for (int bj = 0; bj < 2; ++bj) {
#pragma unroll
            for (int ai = 0; ai < 2; ++ai)
#pragma unroll
                for (int m = 0; m < 4; ++m) { bf16_t* rowp = base + (size_t)(row0 + ai * 128 + m * 16) * ldc + col0 + bj * 128;
                    const f32x4 v0 = acc[ai][bj][m][0], v1 = acc[ai][bj][m][1];
                    u32x4 w; w.x = cvt_pk_bf16(v0[0], v0[1]); w.y = cvt_pk_bf16(v0[2], v0[3]); w.z = cvt_pk_bf16(v1[0], v1[1]); w.w = cvt_pk_bf16(v1[2], v1[3]);
                    *(u32x4*)rowp = w; }
        }
    }
};
struct EpiFf1 {
    static constexpr bool PERM = true, HEADMAP = false;
    bf16_t* HID;
    __device__ __forceinline__ void operator()(const AccT& acc, const Unit& u, int wr, int wc, int fr, int fq) const {
        const int row0 = u.pm * 256 + wr * 64 + fr;
        const int col0 = u.pn * 256 + wc * 32 + 8 * fq;
#pragma unroll
        for (int ai = 0; ai < 2; ++ai)
#pragma unroll
            for (int m = 0; m < 4; ++m) { bf16_t* rowp = HID + (size_t)(row0 + ai * 128 + m * 16) * DFF + col0;
#pragma unroll
                for (int bj = 0; bj < 2; ++bj) { f32x4 v0 = acc[ai][bj][m][0], v1 = acc[ai][bj][m][1];
#pragma unroll
                    for (int j = 0; j < 4; ++j) { const float a = fmaxf(v0[j], 0.f), b = fmaxf(v1[j], 0.f); v0[j] = a * a; v1[j] = b * b; }
                    u32x4 w; w.x = cvt_pk_bf16(v0[0], v0[1]); w.y = cvt_pk_bf16(v0[2], v0[3]); w.z = cvt_pk_bf16(v1[0], v1[1]); w.w = cvt_pk_bf16(v1[2], v1[3]);
                    *(u32x4*)(rowp + bj * 128) = w; } }
    }
};
struct EpiRes {
    static constexpr bool PERM = false, HEADMAP = false;
    float* out; const float* xp; const float* xs; const float* mod; int gate_off;
    __device__ __forceinline__ void operator()(const AccT& acc, const Unit& u, int wr, int wc, int fr, int fq) const {
        const int row0 = u.pm * 256 + wr * 64 + fr, col0 = u.pn * 256 + wc * 32 + 4 * fq;
        const int sq = seq_of_row(u.pm * 256);
        const float* gp = mod + (size_t)sq * 6144 + gate_off + col0;
        f32x4 gv[2][2];
#pragma unroll
        for (int bj = 0; bj < 2; ++bj)
#pragma unroll
            for (int n = 0; n < 2; ++n) gv[bj][n] = *(const f32x4*)(gp + bj * 128 + n * 16);
#pragma unroll
        for (int ai = 0; ai < 2; ++ai)
#pragma unroll
            for (int m = 0; m < 4; ++m) { const int row = row0 + ai * 128 + m * 16;
                float* op = out + (size_t)row * DM + col0;
                const float* rp = xp ? (row < NP ? xp + (size_t)row * DM : xs + (size_t)(row - NP) * DM) + col0 : op;
#pragma unroll
                for (int bj = 0; bj < 2; ++bj)
#pragma unroll
                    for (int n = 0; n < 2; ++n) {
                        const f32x4 r = xp ? __builtin_nontemporal_load((const f32x4*)(rp + bj * 128 + n * 16)) : *(const f32x4*)(rp + bj * 128 + n * 16);
                        const f32x4 o = r + gv[bj][n] * acc[ai][bj][m][n];
                        if (xp) *(f32x4*)(op + bj * 128 + n * 16) = o; else __builtin_nontemporal_store(o, (f32x4*)(op + bj * 128 + n * 16)); } }
    }
};

__device__ void xpose_tile(LAS float* tile, const float* W, int N, int K, int k0, int n0, bf16_t* Wt) {
    const int tid = threadIdx.x;
#pragma unroll
    for (int i = 0; i < 8; ++i) { const int kk = (tid >> 6) + 8 * i, nn = tid & 63; tile[kk * 65 + nn] = W[(size_t)(k0 + kk) * N + n0 + nn]; }
    __syncthreads();
#pragma unroll
    for (int i = 0; i < 8; ++i) { const int nn = (tid >> 6) + 8 * i, kk = tid & 63; Wt[(size_t)(n0 + nn) * K + k0 + kk] = f2bf(tile[kk * 65 + nn]); }
    __syncthreads();
}
__device__ void phase_prep_weights(const Args& a, LAS unsigned char* lds) {
    LAS float* tile = (LAS float*)lds;
    bf16_t* WIN = (bf16_t*)(a.ws + OFF_WIN); bf16_t* WOUT = (bf16_t*)(a.ws + OFF_WOUT); bf16_t* WFF1 = (bf16_t*)(a.ws + OFF_WFF1); bf16_t* WFF2 = (bf16_t*)(a.ws + OFF_WFF2); bf16_t* WL = (bf16_t*)(a.ws + OFF_WL);
    for (int t = blockIdx.x; t < 3168; t += gridDim.x) {
        if (t < 864) { const int kt = t / 54, ntl = t % 54; xpose_tile(tile, a.in[I_WIN], NIN, 1024, kt * 64, ntl * 64, WIN); }
        else if (t < 1120) { const int u = t - 864; xpose_tile(tile, a.in[I_WOUT], 1024, 1024, (u / 16) * 64, (u % 16) * 64, WOUT); }
        else if (t < 2144) { const int u = t - 1120; xpose_tile(tile, a.in[I_WFF1], 4096, 1024, (u / 64) * 64, (u % 64) * 64, WFF1); }
        else { const int u = t - 2144; xpose_tile(tile, a.in[I_WFF2], 1024, 4096, (u / 16) * 64, (u % 16) * 64, WFF2); }
    }
    const int gtid = blockIdx.x * 512 + threadIdx.x, gn = gridDim.x * 512;
    if (gtid < 64) ((int*)(a.ws + OFF_FLAG))[gtid] = 0;
    for (int i = gtid; i < 128 * 1024; i += gn) WIN[(size_t)NIN * 1024 + i] = 0;
    for (int i = gtid; i < 2560 * 384; i += gn) {
        const int n = i / 384, kc = i % 384; float v = 0.f;
        if (n < 512) { if (kc < 64) v = a.in[I_WUP][(size_t)(0 * 64 + kc) * 512 + n]; }
        else if (n < 1024) { if (kc >= 64 && kc < 128) v = a.in[I_WUP][(size_t)(1 * 64 + kc - 64) * 512 + (n - 512)]; }
        else if (n < 1536) { if (kc >= 128 && kc < 192) v = a.in[I_AUP][(size_t)(0 * 64 + kc - 128) * 512 + (n - 1024)]; }
        else if (n < 2048) { if (kc >= 192 && kc < 256) v = a.in[I_AUP][(size_t)(1 * 64 + kc - 192) * 512 + (n - 1536)]; }
        else { if (kc >= 256) v = a.in[I_GUP][(size_t)(kc - 256) * 512 + (n - 2048)]; }
        WL[i] = f2bf(v);
    }
}
__device__ void phase_mod(const Args& a, LAS unsigned char* lds) {
    float* MOD = (float*)(a.ws + OFF_MOD);
    const int wave = threadIdx.x >> 6, lane = threadIdx.x & 63;
    LAS float* sl = (LAS float*)lds + wave * (64 * 36);
    for (int it = blockIdx.x; it < 96; it += gridDim.x) {
        const int j0 = it * 64;
        float acc[36];
#pragma unroll
        for (int b = 0; b < 36; ++b) acc[b] = 0.f;
        for (int half = 0; half < 2; ++half) {
            const int k0 = wave * 128 + half * 64;
#pragma unroll 1
            for (int b = 0; b < 36; ++b) { float sv = 0.f;
                if (b < NSEQ) { const float c = (b == 0) ? a.in[I_CP][k0 + lane] : a.in[I_CS][(size_t)(b - 1) * DM + k0 + lane]; sv = c / (1.f + __expf(-c)); }
                sl[lane * 36 + b] = sv; }
            asm volatile("s_waitcnt lgkmcnt(0)" ::: "memory");
#pragma unroll 1
            for (int k = 0; k < 64; ++k) { const float wv = a.in[I_WADA][(size_t)(k0 + k) * 6144 + j0 + lane];
                const LAS f32x4* sp = (const LAS f32x4*)(sl + k * 36);
#pragma unroll
                for (int q = 0; q < 9; ++q) { const f32x4 s4 = sp[q]; acc[4 * q] += s4[0] * wv; acc[4 * q + 1] += s4[1] * wv; acc[4 * q + 2] += s4[2] * wv; acc[4 * q + 3] += s4[3] * wv; } }
            asm volatile("s_waitcnt lgkmcnt(0)" ::: "memory");
        }
        __syncthreads();
        LAS float* ex = (LAS float*)lds;
#pragma unroll
        for (int b = 0; b < NSEQ; ++b) ex[wave * (NSEQ * 64) + b * 64 + lane] = acc[b];
        __syncthreads();
        for (int idx = threadIdx.x; idx < NSEQ * 64; idx += 512) { float sm = a.in[I_BADA][j0 + (idx & 63)];
#pragma unroll
            for (int w = 0; w < 8; ++w) sm += ex[w * (NSEQ * 64) + idx];
            MOD[(size_t)(idx >> 6) * 6144 + j0 + (idx & 63)] = sm; }
        __syncthreads();
    }
}

__device__ void phase_norm(const Args& a, const float* xp, const float* xs, const float* g, int sh_off, int sc_off) {
    const float* MOD = (const float*)(a.ws + OFF_MOD); bf16_t* H = (bf16_t*)(a.ws + OFF_H);
    const int wave = threadIdx.x >> 6, lane = threadIdx.x & 63;
    for (int row = blockIdx.x * 8 + wave; row < NTOK; row += gridDim.x * 8) {
        const float* xr = (row < NP) ? xp + (size_t)row * DM : xs + (size_t)(row - NP) * DM;
        const float* mr = MOD + (size_t)seq_of_row(row) * 6144;
        f32x4 v[4]; float ss = 0.f;
#pragma unroll
        for (int i = 0; i < 4; ++i) { v[i] = __builtin_nontemporal_load((const f32x4*)(xr + i * 256 + lane * 4)); ss += v[i][0] * v[i][0] + v[i][1] * v[i][1] + v[i][2] * v[i][2] + v[i][3] * v[i][3]; }
        ss = wave_sum(ss);
        const float rinv = rsqrtf(ss * (1.f / DM) + NORM_EPS);
#pragma unroll
        for (int i = 0; i < 4; ++i) { const int c = i * 256 + lane * 4;
            const f32x4 gg = *(const f32x4*)(g + c), sc = *(const f32x4*)(mr + sc_off + c), sh = *(const f32x4*)(mr + sh_off + c);
            f32x4 h;
#pragma unroll
            for (int j = 0; j < 4; ++j) h[j] = v[i][j] * rinv * gg[j] * (1.f + sc[j]) + sh[j];
            u32x2 w; w.x = cvt_pk_bf16(h[0], h[1]); w.y = cvt_pk_bf16(h[2], h[3]);
            *(u32x2*)(H + (size_t)row * DM + c) = w; }
    }
}

__device__ void phase_post_in(const Args& a) {
    const bf16_t* PR = (const bf16_t*)(a.ws + OFF_PR); bf16_t* X5 = (bf16_t*)(a.ws + OFF_X5);
    const int wave = threadIdx.x >> 6, lane = threadIdx.x & 63;
    const int c0 = (lane < 48 ? lane : 0) * 8;
    float mp[8], mn[8];
#pragma unroll
    for (int j = 0; j < 8; ++j) { mp[j] = a.in[I_MUP][1536 + c0 + j]; mn[j] = a.in[I_MUN][1536 + c0 + j]; }
    const int nw = gridDim.x * 8;
    for (int row = blockIdx.x * 8 + wave; row < NTOK; row += 2 * nw) {
        const int row2 = (row + nw < NTOK) ? row + nw : row;
        u32x4 cu[2], pv[2], nx[2]; int rr[2]; rr[0] = row; rr[1] = row2;
#pragma unroll
        for (int q = 0; q < 2; ++q) { const int r = rr[q];
            int pos, S; if (r < NP) { pos = r; S = NP; } else { pos = (r - NP) % SS; S = SS; }
            const bf16_t* pr = PR + (size_t)r * 1920 + 1536 + c0;
            cu[q] = *(const u32x4*)pr;
            pv[q] = pos > 0 ? *(const u32x4*)(pr - 1920) : (u32x4){0u, 0u, 0u, 0u};
            nx[q] = pos < S - 1 ? *(const u32x4*)(pr + 1920) : (u32x4){0u, 0u, 0u, 0u}; }
#pragma unroll
        for (int q = 0; q < 2; ++q) {
            if (q == 1 && row2 == row) break;
            float x[8];
#pragma unroll
            for (int j = 0; j < 4; ++j) { const float c_lo = lo_bf(cu[q][j]), c_hi = hi_bf(cu[q][j]);
                x[2 * j] = c_lo + mp[2 * j] * (lo_bf(pv[q][j]) - c_lo) + mn[2 * j] * (lo_bf(nx[q][j]) - c_lo);
                x[2 * j + 1] = c_hi + mp[2 * j + 1] * (hi_bf(pv[q][j]) - c_hi) + mn[2 * j + 1] * (hi_bf(nx[q][j]) - c_hi); }
            if (lane < 16) {
#pragma unroll
                for (int j = 0; j < 8; ++j) x[j] = tanhf(x[j]);
            } else if (lane >= 32) {
#pragma unroll
                for (int j = 0; j < 8; ++j) x[j] = 1.f / (1.f + __expf(-x[j]));
            }
            u32x4 w; w.x = cvt_pk_bf16(x[0], x[1]); w.y = cvt_pk_bf16(x[2], x[3]); w.z = cvt_pk_bf16(x[4], x[5]); w.w = cvt_pk_bf16(x[6], x[7]);
            if (lane < 48) *(u32x4*)(X5 + (size_t)rr[q] * 384 + c0) = w;
        }
    }
}

__device__ void attn_job4(const Args& a, LAS bf16_t* vlb, int row0, int S, int h, int q0a, float cshift) {
    const bf16_t* QKV = (const bf16_t*)a.out; bf16_t* MIX = (bf16_t*)(a.ws + OFF_H);
    const int lane = threadIdx.x & 63, fr = lane & 15, g = lane >> 4;
    const float slope = exp2f(-(float)(h + 1));
    constexpr int VP = 64;
    const bf16_t* kbase = QKV + (size_t)row0 * 1536 + 512 + h * 64 + g * 8;
    const bf16_t* vbase = QKV + (size_t)row0 * 1536 + 1024 + h * 64;
    int qp[4]; f32x4 O[4][4]; float l[4];
    LAS bf16x8* qlds = (LAS bf16x8*)(vlb + 2 * 32 * VP);
    asm volatile("s_waitcnt lgkmcnt(0)" ::: "memory");
#pragma unroll
    for (int jj = 0; jj < 4; ++jj) { qp[jj] = q0a + 4 * jj + 16 * fr;
        const bf16_t* qrow = QKV + (size_t)(row0 + qp[jj]) * 1536 + h * 64;
        qlds[(jj * 2 + 0) * 64 + lane] = *(const bf16x8*)(qrow + g * 8); qlds[(jj * 2 + 1) * 64 + lane] = *(const bf16x8*)(qrow + 32 + g * 8); l[jj] = 0.f;
#pragma unroll
        for (int i = 0; i < 4; ++i) O[jj][i] = (f32x4){0.f, 0.f, 0.f, 0.f}; }
    bf16x8 nka0[2], nka1[2], nkb0[2], nkb1[2]; u32x4 nvv[2][4];
    const float slope2 = slope * 1.44269504f, c2 = cshift * 1.44269504f;
    const unsigned traddr = (unsigned)(unsigned long)vlb + (unsigned)((8 * g + ((lane & 15) >> 2)) * (VP * 2) + 8 * (lane & 3));
#define LOAD_SET(KJ, Q0S, D_, TP_) { const int base_ = (Q0S) - 64 * (D_); \
        int kpa = base_ + (D_) * (16 * (TP_) + fr), kpb = kpa + 16 * (D_); kpa = min(max(kpa, 0), S - 1); kpb = min(max(kpb, 0), S - 1); \
        const bf16_t* ka = kbase + (size_t)kpa * 1536; const bf16_t* kb = kbase + (size_t)kpb * 1536; \
        nka0[KJ] = *(const bf16x8*)ka; nka1[KJ] = *(const bf16x8*)(ka + 32); nkb0[KJ] = *(const bf16x8*)kb; nkb1[KJ] = *(const bf16x8*)(kb + 32); \
        _Pragma("unroll") for (int i = 0; i < 4; ++i) { const int idx = lane + 64 * i, rr = idx >> 3, chk = idx & 7; \
            int kp = base_ + (D_) * (16 * (TP_) + rr); kp = min(max(kp, 0), S - 1); nvv[KJ][i] = *(const u32x4*)(vbase + (size_t)kp * 1536 + chk * 8); } }
#define V_TO_LDS(KJ) _Pragma("unroll") for (int i = 0; i < 4; ++i) { const int idx = lane + 64 * i, rr = idx >> 3, chk = idx & 7; \
            const int rho = 8 * ((rr & 15) >> 2) + 4 * (rr >> 4) + (rr & 3); \
            *(LAS u32x4*)(vlb + (KJ) * (32 * VP) + rho * VP + chk * 8) = nvv[KJ][i]; }
#define QK_SOFTMAX(JJ, KJ, SHIFT, D_, TP_, PF) { \
        const bf16x8 q0_ = qlds[((JJ) * 2 + 0) * 64 + lane], q1_ = qlds[((JJ) * 2 + 1) * 64 + lane]; \
        f32x4 sa_ = __builtin_amdgcn_mfma_f32_16x16x32_bf16(nka0[KJ], q0_, (f32x4){0.f, 0.f, 0.f, 0.f}, 0, 0, 0); sa_ = __builtin_amdgcn_mfma_f32_16x16x32_bf16(nka1[KJ], q1_, sa_, 0, 0, 0); \
        f32x4 sb_ = __builtin_amdgcn_mfma_f32_16x16x32_bf16(nkb0[KJ], q0_, (f32x4){0.f, 0.f, 0.f, 0.f}, 0, 0, 0); sb_ = __builtin_amdgcn_mfma_f32_16x16x32_bf16(nkb1[KJ], q1_, sb_, 0, 0, 0); \
        const float fd_ = (float)(D_); \
        const float fR0 = (float)((D_) * (16 * (TP_) + 4 * g - 64) - 16 * fr) - (float)(SHIFT); \
        const float lo = fmaxf(-64.f * fd_, -(float)qp[JJ]), hi = fminf(64.f * fd_, (float)(S - 1 - qp[JJ])); \
        float pa[4], pb[4]; \
        _Pragma("unroll") for (int j = 0; j < 4; ++j) { \
            const float r1 = fR0 + (float)j * fd_, r2 = r1 + 16.f * fd_; \
            const float e1 = __builtin_amdgcn_exp2f(__builtin_fmaf(-slope2, fabsf(r1), __builtin_fmaf(sa_[j], 1.44269504f, -c2))); \
            const float e2 = __builtin_amdgcn_exp2f(__builtin_fmaf(-slope2, fabsf(r2), __builtin_fmaf(sb_[j], 1.44269504f, -c2))); \
            pa[j] = (r1 >= lo && r1 <= hi) ? e1 : 0.f; pb[j] = (r2 >= lo && r2 <= hi) ? e2 : 0.f; \
            l[JJ] += pa[j] + pb[j]; } \
        u32x4 pw; pw.x = cvt_pk_bf16(pa[0], pa[1]); pw.y = cvt_pk_bf16(pa[2], pa[3]); pw.z = cvt_pk_bf16(pb[0], pb[1]); pw.w = cvt_pk_bf16(pb[2], pb[3]); \
        __builtin_memcpy(&PF, &pw, 16); }
#define TR_READ2(KJ, DB0, TV) { _Pragma("unroll") for (int db = 0; db < 2; ++db) _Pragma("unroll") for (int t = 0; t < 2; ++t) \
            asm volatile("ds_read_b64_tr_b16 %0, %1" : "=v"(TV[db][t]) : "v"(traddr + (unsigned)((KJ) * (32 * VP * 2) + t * (4 * VP * 2) + ((DB0) + db) * 32))); \
        asm volatile("s_waitcnt lgkmcnt(0)" : "+v"(TV[0][0]), "+v"(TV[0][1]), "+v"(TV[1][0]), "+v"(TV[1][1]) :: "memory"); }
#define PV2(JJ, DB0, TV, PF) _Pragma("unroll") for (int db = 0; db < 2; ++db) { \
            u32x4 vw; vw.x = TV[db][0].x; vw.y = TV[db][0].y; vw.z = TV[db][1].x; vw.w = TV[db][1].y; \
            bf16x8 vf; __builtin_memcpy(&vf, &vw, 16); \
            O[JJ][(DB0) + db] = __builtin_amdgcn_mfma_f32_16x16x32_bf16(vf, PF, O[JJ][(DB0) + db], 0, 0, 0); }
    LOAD_SET(0, q0a, 1, 0)
    for (int st = 0; st < 18; ++st) {
        const int d = st < 12 ? 1 : 4, tp = st < 12 ? 2 * st : 2 * (st - 12);
        bf16x8 pf0, pf1, pf2, pf3;
        QK_SOFTMAX(0, 0, 0, d, tp, pf0) QK_SOFTMAX(1, 0, 4, d, tp, pf1) QK_SOFTMAX(2, 0, 8, d, tp, pf2) QK_SOFTMAX(3, 0, 12, d, tp, pf3)
        asm volatile("s_waitcnt lgkmcnt(0)" ::: "memory");
        V_TO_LDS(0)
        asm volatile("" ::: "memory");
        if (st + 1 < 18) { const int sn = st + 1, dn = sn < 12 ? 1 : 4, tn = sn < 12 ? 2 * sn : 2 * (sn - 12); LOAD_SET(0, q0a, dn, tn) }
        else { LOAD_SET(0, q0a, 16, 0) }
        asm volatile("s_waitcnt lgkmcnt(0)" ::: "memory");
        u32x2 tv[2][2];
        TR_READ2(0, 0, tv) PV2(0, 0, tv, pf0) PV2(1, 0, tv, pf1) PV2(2, 0, tv, pf2) PV2(3, 0, tv, pf3)
        TR_READ2(0, 2, tv) PV2(0, 2, tv, pf0) PV2(1, 2, tv, pf1) PV2(2, 2, tv, pf2) PV2(3, 2, tv, pf3)
    }
    LOAD_SET(1, q0a + 4, 16, 0)
    for (int s5 = 0; s5 < 5; ++s5) {
        const int tp = 2 * s5;
        {   bf16x8 pfa, pfb;
            QK_SOFTMAX(0, 0, 0, 16, tp, pfa) QK_SOFTMAX(1, 1, 0, 16, tp, pfb)
            asm volatile("s_waitcnt lgkmcnt(0)" ::: "memory");
            V_TO_LDS(0) V_TO_LDS(1)
            asm volatile("" ::: "memory");
            LOAD_SET(0, q0a + 8, 16, tp) LOAD_SET(1, q0a + 12, 16, tp)
            asm volatile("s_waitcnt lgkmcnt(0)" ::: "memory");
            u32x2 tv[2][2];
            TR_READ2(0, 0, tv) PV2(0, 0, tv, pfa) TR_READ2(0, 2, tv) PV2(0, 2, tv, pfa)
            TR_READ2(1, 0, tv) PV2(1, 0, tv, pfb) TR_READ2(1, 2, tv) PV2(1, 2, tv, pfb) }
        {   bf16x8 pfa, pfb;
            QK_SOFTMAX(2, 0, 0, 16, tp, pfa) QK_SOFTMAX(3, 1, 0, 16, tp, pfb)
            asm volatile("s_waitcnt lgkmcnt(0)" ::: "memory");
            V_TO_LDS(0) V_TO_LDS(1)
            asm volatile("" ::: "memory");
            { const int tn = s5 < 4 ? tp + 2 : tp; LOAD_SET(0, q0a, 16, tn) LOAD_SET(1, q0a + 4, 16, tn) }
            asm volatile("s_waitcnt lgkmcnt(0)" ::: "memory");
            u32x2 tv[2][2];
            TR_READ2(0, 0, tv) PV2(2, 0, tv, pfa) TR_READ2(0, 2, tv) PV2(2, 2, tv, pfa)
            TR_READ2(1, 0, tv) PV2(3, 0, tv, pfb) TR_READ2(1, 2, tv) PV2(3, 2, tv, pfb) }
    }
#undef LOAD_SET
#undef V_TO_LDS
#undef QK_SOFTMAX
#undef TR_READ2
#undef PV2
    const float* beta = a.in[I_BETA] + h * 64;
#pragma unroll
    for (int jj = 0; jj < 4; ++jj) {
        float ls = l[jj]; ls += __shfl_xor(ls, 16); ls += __shfl_xor(ls, 32);
        const float inv = 1.f / ls;
        bf16_t* op = MIX + (size_t)(row0 + qp[jj]) * DM + h * 64;
#pragma unroll
        for (int db = 0; db < 4; ++db) { const int dd = 16 * db + 4 * g;
            u32x2 w; w.x = cvt_pk_bf16(O[jj][db][0] * inv * beta[dd], O[jj][db][1] * inv * beta[dd + 1]); w.y = cvt_pk_bf16(O[jj][db][2] * inv * beta[dd + 2], O[jj][db][3] * inv * beta[dd + 3]);
            *(u32x2*)(op + dd) = w; }
    }
}
__device__ void phase_attn(const Args& a, LAS unsigned char* lds) {
    const int wave = threadIdx.x >> 6, lane = threadIdx.x & 63;
    LAS bf16_t* vl = (LAS bf16_t*)(lds + wave * 16384);
    const float gq = wave_max(fabsf(a.in[I_QG][lane])), gk = wave_max(fabsf(a.in[I_KG][lane]));
    const float cshift = 8.f * gq * gk;
    const int njobs = (NTOK / 256) * 8 * 4;
    for (int j = blockIdx.x * 8 + wave; j < njobs; j += gridDim.x * 8) {
        const int r = j & 3, h = (j >> 2) & 7, tb = j >> 5;
        const int rowb = tb * 256;
        int row0, S; if (rowb < NP) { row0 = 0; S = NP; } else { row0 = NP + ((rowb - NP) / SS) * SS; S = SS; }
        attn_job4(a, vl, row0, S, h, rowb - row0 + r, cshift);
    }
}

__device__ __forceinline__ float dpp_x1(float x) { return __int_as_float(__builtin_amdgcn_update_dpp(0, __float_as_int(x), 0xB1, 0xF, 0xF, true)); }
__device__ __forceinline__ float dpp_x2(float x) { return __int_as_float(__builtin_amdgcn_update_dpp(0, __float_as_int(x), 0x4E, 0xF, 0xF, true)); }
__device__ __forceinline__ float quad_sum(float x) { x += dpp_x1(x); x += dpp_x2(x); return x; }
constexpr int SEG = 256, NSEGP = NP / SEG;

template <int MODE>
__device__ void scan_job(const Args& a, LAS float* wl, int row0, int S, int h, int dir, int i0, int n, const float* startp, float* endp, bool emit) {
    const bf16_t* PR = (const bf16_t*)(a.ws + OFF_PR); const bf16_t* LORA = (const bf16_t*)(a.ws + OFF_LORA);
    bf16_t* Y = (bf16_t*)(a.ws + OFF_Y); float* CB = (float*)(a.ws + OFF_C);
    const int lane = threadIdx.x & 63, ch = h * 64 + lane, qd = lane >> 2, kq = lane & 3;
    const float mpr_r = a.in[I_MUP][ch], mnx_r = a.in[I_MUN][ch], mpr_k = a.in[I_MUP][512 + ch], mnx_k = a.in[I_MUN][512 + ch], mpr_v = a.in[I_MUP][1024 + ch], mnx_v = a.in[I_MUN][1024 + ch];
    const float kkc = a.in[I_KK][ch], kac = a.in[I_KA][ch], rkc = a.in[I_RK][ch];
    const float w0c = a.in[I_W0][dir * 512 + ch], a0c = a.in[I_A0][dir * 512 + ch];
    f32x2 St[4][8];
#pragma unroll
    for (int i = 0; i < 4; ++i)
#pragma unroll
        for (int k2 = 0; k2 < 8; ++k2) {
            if (MODE == 1) { const int r = 4 * qd + i, c = kq * 16 + 2 * k2; St[i][k2] = (f32x2){r == c ? 1.f : 0.f, r == c + 1 ? 1.f : 0.f}; }
            else if (startp) St[i][k2] = *(const f32x2*)(startp + (4 * qd + i) * 64 + kq * 16 + 2 * k2);
            else St[i][k2] = (f32x2){0.f, 0.f};
        }
    const int sd = dir ? -1 : 1;
    const int t0 = dir ? S - 1 - i0 : i0;
    float rb = 0.f, kb = 0.f, vb = 0.f, rc, kc, vc, ra = 0.f, ka = 0.f, va = 0.f;
    { const bf16_t* p = PR + (size_t)(row0 + t0) * 1920 + ch; rc = bf2f(p[0]); kc = bf2f(p[512]); vc = bf2f(p[1024]);
      const int tb = t0 - sd, ta = t0 + sd;
      if (tb >= 0 && tb < S) { const bf16_t* q = PR + (size_t)(row0 + tb) * 1920 + ch; rb = bf2f(q[0]); kb = bf2f(q[512]); vb = bf2f(q[1024]); }
      if (ta >= 0 && ta < S) { const bf16_t* q = PR + (size_t)(row0 + ta) * 1920 + ch; ra = bf2f(q[0]); ka = bf2f(q[512]); va = bf2f(q[1024]); } }
    bf16_t nr[4], nk[4], nv[4], lw[4], la[4];
#define SCAN_LOADS(IB, R_, K_, V_, W_, A_) _Pragma("unroll") for (int u = 0; u < 4; ++u) { const int t = t0 + sd * ((IB) + u), t2 = t + 2 * sd; const bool ok = (t2 >= 0 && t2 < S); \
            const bf16_t* p = PR + (size_t)(row0 + (ok ? t2 : t)) * 1920 + ch; \
            R_[u] = ok ? p[0] : (bf16_t)0; K_[u] = ok ? p[512] : (bf16_t)0; V_[u] = ok ? p[1024] : (bf16_t)0; \
            const bf16_t* lp = LORA + (size_t)(row0 + t) * 2048 + dir * 512 + ch; W_[u] = lp[0]; A_[u] = lp[1024]; }
    SCAN_LOADS(0, nr, nk, nv, lw, la)
    for (int ib = 0; ib < n; ib += 4) {
        bf16_t pr_[4], pk_[4], pv_[4], pw_[4], pa_[4];
        { const int ibn = (ib + 4 < n) ? ib + 4 : ib; SCAN_LOADS(ibn, pr_, pk_, pv_, pw_, pa_) }
#pragma unroll
        for (int u = 0; u < 4; ++u) {
            const int t = t0 + sd * (ib + u);
            const float rp = dir ? ra : rb, rn = dir ? rb : ra, kp = dir ? ka : kb, kn = dir ? kb : ka, vp = dir ? va : vb, vn = dir ? vb : va;
            const float r = rc + mpr_r * (rp - rc) + mnx_r * (rn - rc);
            const float k = kc + mpr_k * (kp - kc) + mnx_k * (kn - kc);
            const float v = vc + mpr_v * (vp - vc) + mnx_v * (vn - vc);
            const float wraw = bf2f(lw[u]) + w0c, apre = bf2f(la[u]) + a0c;
            const float w = __expf(-0.60653066f * __builtin_amdgcn_rcpf(1.f + __expf(-wraw)));
            const float av = __builtin_amdgcn_rcpf(1.f + __expf(-apre));
            const float kkr = k * kkc; const float ssq = wave_sum(kkr * kkr);
            const float kk = kkr * rsqrtf(fmaxf(ssq, 1e-24f));
            const float kd = k * (1.f + (av - 1.f) * kac);
            const float bb = kk * av;
            LAS float* o = wl + u * 384;
            o[lane] = w; o[64 + lane] = kk; o[128 + lane] = bb; o[192 + lane] = kd; o[256 + lane] = r; o[320 + lane] = v;
            if (emit) { const float cd = wave_sum(r * kd * rkc); if (lane == 0) CB[((size_t)dir * NTOK + row0 + t) * 8 + h] = cd; }
            rb = rc; kb = kc; vb = vc; rc = ra; kc = ka; vc = va; ra = bf2f(nr[u]); ka = bf2f(nk[u]); va = bf2f(nv[u]);
        }
        asm volatile("s_waitcnt lgkmcnt(0)" ::: "memory");
#pragma unroll
        for (int u = 0; u < 4; ++u) {
            const LAS f32x4* V4 = (const LAS f32x4*)(wl + u * 384);
            f32x4 k4[4];
#pragma unroll
            for (int j = 0; j < 4; ++j) k4[j] = V4[16 + kq * 4 + j];
            float sa[4];
#pragma unroll
            for (int i = 0; i < 4; ++i) { f32x2 a2 = (f32x2){0.f, 0.f};
#pragma unroll
                for (int j = 0; j < 4; ++j) { a2 += St[i][2 * j] * (f32x2){k4[j][0], k4[j][1]}; a2 += St[i][2 * j + 1] * (f32x2){k4[j][2], k4[j][3]}; }
                sa[i] = quad_sum(a2[0] + a2[1]); }
            f32x4 w4[4], b4[4], d4[4], r4[4];
#pragma unroll
            for (int j = 0; j < 4; ++j) { w4[j] = V4[kq * 4 + j]; b4[j] = V4[32 + kq * 4 + j]; if (MODE == 0) { d4[j] = V4[48 + kq * 4 + j]; r4[j] = V4[64 + kq * 4 + j]; } }
            f32x4 vr = (f32x4){0.f, 0.f, 0.f, 0.f};
            if (MODE == 0) vr = V4[80 + qd];
            float yv[4];
#pragma unroll
            for (int i = 0; i < 4; ++i) {
                const f32x2 nsa = (f32x2){-sa[i], -sa[i]}, vv2 = (f32x2){vr[i], vr[i]};
                f32x2 y2 = (f32x2){0.f, 0.f};
#pragma unroll
                for (int j = 0; j < 4; ++j) {
                    f32x2 ta = nsa * (f32x2){b4[j][0], b4[j][1]}, tb = nsa * (f32x2){b4[j][2], b4[j][3]};
                    if (MODE == 0) { ta += vv2 * (f32x2){d4[j][0], d4[j][1]}; tb += vv2 * (f32x2){d4[j][2], d4[j][3]}; }
                    St[i][2 * j] = St[i][2 * j] * (f32x2){w4[j][0], w4[j][1]} + ta; St[i][2 * j + 1] = St[i][2 * j + 1] * (f32x2){w4[j][2], w4[j][3]} + tb;
                    if (MODE == 0) { y2 += St[i][2 * j] * (f32x2){r4[j][0], r4[j][1]}; y2 += St[i][2 * j + 1] * (f32x2){r4[j][2], r4[j][3]}; }
                }
                yv[i] = y2[0] + y2[1];
            }
            if (MODE == 0 && emit) {
#pragma unroll
                for (int i = 0; i < 4; ++i) yv[i] = quad_sum(yv[i]);
                const int t = t0 + sd * (ib + u);
                if (kq == 0) { u32x2 w; w.x = cvt_pk_bf16(yv[0], yv[1]); w.y = cvt_pk_bf16(yv[2], yv[3]);
                    *(u32x2*)(Y + ((size_t)dir * NTOK + row0 + t) * 512 + h * 64 + 4 * qd) = w; }
            }
        }
        asm volatile("s_waitcnt lgkmcnt(0)" ::: "memory");
#pragma unroll
        for (int u = 0; u < 4; ++u) { nr[u] = pr_[u]; nk[u] = pk_[u]; nv[u] = pv_[u]; lw[u] = pw_[u]; la[u] = pa_[u]; }
    }
#undef SCAN_LOADS
    if (endp) {
#pragma unroll
        for (int i = 0; i < 4; ++i)
#pragma unroll
            for (int k2 = 0; k2 < 8; ++k2) *(f32x2*)(endp + (4 * qd + i) * 64 + kq * 16 + 2 * k2) = St[i][k2];
    }
}
__device__ __forceinline__ float* sum_slot(const Args& a, int chain, int seg, int which) { return (float*)(a.ws + OFF_SUM) + ((size_t)(chain * NSEGP + seg) * 2 + which) * 4096; }

__device__ void scan_job_pq(const Args& a, LAS float* wl, int row0, int S, int h, int dir, int i0, int n, int half, float* endP, float* endQ) {
    const bf16_t* PR = (const bf16_t*)(a.ws + OFF_PR); const bf16_t* LORA = (const bf16_t*)(a.ws + OFF_LORA);
    const int lane = threadIdx.x & 63, ch = h * 64 + lane, qd = lane >> 2, kq = lane & 3;
    const float mpr_k = a.in[I_MUP][512 + ch], mnx_k = a.in[I_MUN][512 + ch], mpr_v = a.in[I_MUP][1024 + ch], mnx_v = a.in[I_MUN][1024 + ch];
    const float kkc = a.in[I_KK][ch], kac = a.in[I_KA][ch];
    const float w0c = a.in[I_W0][dir * 512 + ch], a0c = a.in[I_A0][dir * 512 + ch];
    f32x2 Sp[2][8], Sq[2][8];
#pragma unroll
    for (int i = 0; i < 2; ++i)
#pragma unroll
        for (int k2 = 0; k2 < 8; ++k2) { const int r = 4 * qd + 2 * half + i, c = kq * 16 + 2 * k2; Sp[i][k2] = (f32x2){r == c ? 1.f : 0.f, r == c + 1 ? 1.f : 0.f}; Sq[i][k2] = (f32x2){0.f, 0.f}; }
    const int sd = dir ? -1 : 1;
    const int t0 = dir ? S - 1 - i0 : i0;
    float kb = 0.f, vb = 0.f, kc, vc, ka = 0.f, va = 0.f;
    { const bf16_t* p = PR + (size_t)(row0 + t0) * 1920 + ch; kc = bf2f(p[512]); vc = bf2f(p[1024]);
      const int tb = t0 - sd, ta = t0 + sd;
      if (tb >= 0 && tb < S) { const bf16_t* q = PR + (size_t)(row0 + tb) * 1920 + ch; kb = bf2f(q[512]); vb = bf2f(q[1024]); }
      if (ta >= 0 && ta < S) { const bf16_t* q = PR + (size_t)(row0 + ta) * 1920 + ch; ka = bf2f(q[512]); va = bf2f(q[1024]); } }
    bf16_t nk[4], nv[4], lw[4], la[4];
#define PQ_LOADS(IB, K_, V_, W_, A_) _Pragma("unroll") for (int u = 0; u < 4; ++u) { const int t = t0 + sd * ((IB) + u), t2 = t + 2 * sd; const bool ok = (t2 >= 0 && t2 < S); \
            const bf16_t* p = PR + (size_t)(row0 + (ok ? t2 : t)) * 1920 + ch; \
            K_[u] = ok ? p[512] : (bf16_t)0; V_[u] = ok ? p[1024] : (bf16_t)0; \
            const bf16_t* lp = LORA + (size_t)(row0 + t) * 2048 + dir * 512 + ch; W_[u] = lp[0]; A_[u] = lp[1024]; }
    PQ_LOADS(0, nk, nv, lw, la)
    for (int ib = 0; ib < n; ib += 4) {
        bf16_t pk_[4], pv_[4], pw_[4], pa_[4];
        { const int ibn = (ib + 4 < n) ? ib + 4 : ib; PQ_LOADS(ibn, pk_, pv_, pw_, pa_) }
#pragma unroll
        for (int u = 0; u < 4; ++u) {
            const float kp = dir ? ka : kb, kn = dir ? kb : ka, vp = dir ? va : vb, vn = dir ? vb : va;
            const float k = kc + mpr_k * (kp - kc) + mnx_k * (kn - kc);
            const float v = vc + mpr_v * (vp - vc) + mnx_v * (vn - vc);
            const float wraw = bf2f(lw[u]) + w0c, apre = bf2f(la[u]) + a0c;
            const float w = __expf(-0.60653066f * __builtin_amdgcn_rcpf(1.f + __expf(-wraw)));
            const float av = __builtin_amdgcn_rcpf(1.f + __expf(-apre));
            const float kkr = k * kkc; const float ssq = wave_sum(kkr * kkr);
            const float kk = kkr * rsqrtf(fmaxf(ssq, 1e-24f));
            const float kd = k * (1.f + (av - 1.f) * kac);
            const float bb = kk * av;
            LAS float* o = wl + u * 384;
            o[lane] = w; o[64 + lane] = kk; o[128 + lane] = bb; o[192 + lane] = kd; o[320 + lane] = v;
            kb = kc; vb = vc; kc = ka; vc = va; ka = bf2f(nk[u]); va = bf2f(nv[u]);
        }
        asm volatile("s_waitcnt lgkmcnt(0)" ::: "memory");
#pragma unroll
        for (int u = 0; u < 4; ++u) {
            const LAS f32x4* V4 = (const LAS f32x4*)(wl + u * 384);
            __builtin_amdgcn_sched_barrier(0);
            f32x4 k4[4], w4[4], b4[4], d4[4];
#pragma unroll
            for (int j = 0; j < 4; ++j) k4[j] = V4[16 + kq * 4 + j];
            float sap[2], saq[2];
#pragma unroll
            for (int i = 0; i < 2; ++i) { f32x2 ap = (f32x2){0.f, 0.f}, aq = (f32x2){0.f, 0.f};
#pragma unroll
                for (int j = 0; j < 4; ++j) { ap += Sp[i][2 * j] * (f32x2){k4[j][0], k4[j][1]}; ap += Sp[i][2 * j + 1] * (f32x2){k4[j][2], k4[j][3]};
                                              aq += Sq[i][2 * j] * (f32x2){k4[j][0], k4[j][1]}; aq += Sq[i][2 * j + 1] * (f32x2){k4[j][2], k4[j][3]}; }
                sap[i] = quad_sum(ap[0] + ap[1]); saq[i] = quad_sum(aq[0] + aq[1]); }
            __builtin_amdgcn_sched_barrier(0);
#pragma unroll
            for (int j = 0; j < 4; ++j) { w4[j] = V4[kq * 4 + j]; b4[j] = V4[32 + kq * 4 + j]; d4[j] = V4[48 + kq * 4 + j]; }
            const f32x4 vr = V4[80 + qd];
#pragma unroll
            for (int i = 0; i < 2; ++i) {
                const float vsel = half ? (i ? vr[3] : vr[2]) : (i ? vr[1] : vr[0]);
                const f32x2 nsp = (f32x2){-sap[i], -sap[i]}, nsq = (f32x2){-saq[i], -saq[i]}, vv2 = (f32x2){vsel, vsel};
#pragma unroll
                for (int j = 0; j < 4; ++j) {
                    const f32x2 blo = (f32x2){b4[j][0], b4[j][1]}, bhi = (f32x2){b4[j][2], b4[j][3]}, wlo = (f32x2){w4[j][0], w4[j][1]}, whi = (f32x2){w4[j][2], w4[j][3]};
                    Sp[i][2 * j] = Sp[i][2 * j] * wlo + nsp * blo; Sp[i][2 * j + 1] = Sp[i][2 * j + 1] * whi + nsp * bhi;
                    Sq[i][2 * j] = Sq[i][2 * j] * wlo + (vv2 * (f32x2){d4[j][0], d4[j][1]} + nsq * blo); Sq[i][2 * j + 1] = Sq[i][2 * j + 1] * whi + (vv2 * (f32x2){d4[j][2], d4[j][3]} + nsq * bhi);
                }
            }
        }
        asm volatile("s_waitcnt lgkmcnt(0)" ::: "memory");
#pragma unroll
        for (int u = 0; u < 4; ++u) { nk[u] = pk_[u]; nv[u] = pv_[u]; lw[u] = pw_[u]; la[u] = pa_[u]; }
    }
#undef PQ_LOADS
#pragma unroll
    for (int i = 0; i < 2; ++i)
#pragma unroll
        for (int k2 = 0; k2 < 8; ++k2) { *(f32x2*)(endP + (4 * qd + 2 * half + i) * 64 + kq * 16 + 2 * k2) = Sp[i][k2]; *(f32x2*)(endQ + (4 * qd + 2 * half + i) * 64 + kq * 16 + 2 * k2) = Sq[i][k2]; }
}
__device__ void phase_scan_pass1(const Args& a, LAS unsigned char* lds) {
    const int wave = threadIdx.x >> 6;
    LAS float* wl = (LAS float*)(lds + wave * 16384);
    const int njobs = 16 * (NSEGP - 1) * 2;
    for (int j = blockIdx.x * 8 + wave; j < njobs; j += gridDim.x * 8) {
        const int chain = j / ((NSEGP - 1) * 2), rem = j % ((NSEGP - 1) * 2), seg = rem >> 1, half = rem & 1;
        scan_job_pq(a, wl, 0, NP, chain >> 1, chain & 1, seg * SEG, SEG, half, sum_slot(a, chain, seg, 0), sum_slot(a, chain, seg, 1));
    }
}
__device__ void combine_chain(const Args& a, LAS unsigned char* lds, int chain, int q) {
    LAS float* Ss = (LAS float*)lds;
    LAS float* Ps = (LAS float*)(lds + 8192);
    const int tid = threadIdx.x, vl = tid >> 5, v = 16 * q + vl, kb = (tid & 31) * 2;
    { const float* q0 = sum_slot(a, chain, 0, 1);
      for (int i = tid; i < 1024; i += 512) Ss[(i >> 6) * 65 + (i & 63)] = q0[(16 * q + (i >> 6)) * 64 + (i & 63)]; }
    f32x4 np0, np1; f32x2 nc;
    { const float* pj = sum_slot(a, chain, 1, 0); const float* qj = sum_slot(a, chain, 1, 1);
      np0 = *(const f32x4*)(pj + tid * 4); np1 = *(const f32x4*)(pj + 2048 + tid * 4); nc = *(const f32x2*)(qj + v * 64 + kb); }
    for (int j = 1; j < NSEGP - 1; ++j) {
        float* qj = sum_slot(a, chain, j, 1);
        *(LAS f32x4*)(Ps + tid * 4) = np0; *(LAS f32x4*)(Ps + 2048 + tid * 4) = np1;
        f32x2 c = nc;
        if (j + 1 < NSEGP - 1) { const float* pn = sum_slot(a, chain, j + 1, 0); const float* qn = sum_slot(a, chain, j + 1, 1);
            np0 = *(const f32x4*)(pn + tid * 4); np1 = *(const f32x4*)(pn + 2048 + tid * 4); nc = *(const f32x2*)(qn + v * 64 + kb); }
        __syncthreads();
#pragma unroll 16
        for (int m = 0; m < 64; ++m) { const float sv = Ss[vl * 65 + m]; const f32x2 p = *(const LAS f32x2*)(Ps + m * 64 + kb); c += sv * p; }
        __syncthreads();
        *(f32x2*)(qj + v * 64 + kb) = c;
        Ss[vl * 65 + kb] = c[0]; Ss[vl * 65 + kb + 1] = c[1];
    }
    __threadfence();
    __syncthreads();
    if (tid == 0) __hip_atomic_fetch_add((int*)(a.ws + OFF_FLAG) + chain, 1, __ATOMIC_RELEASE, __HIP_MEMORY_SCOPE_AGENT);
    __syncthreads();
}
__device__ void rwkv_out_slice(const Args& a, int row0, int h);
struct CoopJob { int row0, S, h, dir, i0; const float* startp; };
__device__ void scan_coop(const Args& a, LAS unsigned char* lds, const CoopJob jA, const CoopJob jB, int n) {
    const bf16_t* PR = (const bf16_t*)(a.ws + OFF_PR); const bf16_t* LORA = (const bf16_t*)(a.ws + OFF_LORA);
    bf16_t* Y = (bf16_t*)(a.ws + OFF_Y); float* CB = (float*)(a.ws + OFF_C);
    const int wave = __builtin_amdgcn_readfirstlane(threadIdx.x >> 6), lane = threadIdx.x & 63, c = wave >> 2, rg = wave & 3, qd = lane >> 2, kq = lane & 3;
    const int row0 = c ? jB.row0 : jA.row0, S = c ? jB.S : jA.S, h = c ? jB.h : jA.h, dir = c ? jB.dir : jA.dir, i0 = c ? jB.i0 : jA.i0;
    const float* startp = c ? jB.startp : jA.startp;
    LAS float* buf = (LAS float*)lds + c * (2 * 8 * 384);
    const int ch = h * 64 + lane;
    const float mpr_r = a.in[I_MUP][ch], mnx_r = a.in[I_MUN][ch], mpr_k = a.in[I_MUP][512 + ch], mnx_k = a.in[I_MUN][512 + ch], mpr_v = a.in[I_MUP][1024 + ch], mnx_v = a.in[I_MUN][1024 + ch];
    const float kkc = a.in[I_KK][ch], kac = a.in[I_KA][ch], rkc = a.in[I_RK][ch];
    const float w0c = a.in[I_W0][dir * 512 + ch], a0c = a.in[I_A0][dir * 512 + ch];
    const int myrow = 16 * rg + qd;
    f32x2 St[8];
#pragma unroll
    for (int k2 = 0; k2 < 8; ++k2) St[k2] = startp ? *(const f32x2*)(startp + myrow * 64 + kq * 16 + 2 * k2) : (f32x2){0.f, 0.f};
    const int sd = dir ? -1 : 1, t0 = dir ? S - 1 - i0 : i0;
    bf16_t lr[2][3], lk[2][3], lv[2][3], lw[2], la[2];
    const bf16_t* prp = PR + (size_t)(row0 + t0 + sd * rg) * 1920 + ch;
    const bf16_t* lop = LORA + (size_t)(row0 + t0 + sd * rg) * 2048 + dir * 512 + ch;
    float* cbp = CB + ((size_t)dir * NTOK + row0 + t0 + sd * rg) * 8 + h;
    bf16_t* ypw = Y + ((size_t)dir * NTOK + row0 + t0) * 512 + h * 64 + myrow;
    const long rstep = (long)sd * 1920, lstep = (long)sd * 2048;
#define COOP_LOADS(IB, R_, K_, V_, W_, A_) _Pragma("unroll") for (int e = 0; e < 2; ++e) { const int t = t0 + sd * ((IB) + 4 * e + rg); const bool okp = t > 0, okn = t < S - 1; \
        const bf16_t* p = prp + rstep * ((IB) + 4 * e); \
        R_[e][1] = p[0]; K_[e][1] = p[512]; V_[e][1] = p[1024]; \
        const bf16_t r0_ = p[-1920], k0_ = p[-1920 + 512], v0_ = p[-1920 + 1024], r2_ = p[1920], k2_ = p[1920 + 512], v2_ = p[1920 + 1024]; \
        R_[e][0] = okp ? r0_ : (bf16_t)0; K_[e][0] = okp ? k0_ : (bf16_t)0; V_[e][0] = okp ? v0_ : (bf16_t)0; \
        R_[e][2] = okn ? r2_ : (bf16_t)0; K_[e][2] = okn ? k2_ : (bf16_t)0; V_[e][2] = okn ? v2_ : (bf16_t)0; \
        const bf16_t* lp = lop + lstep * ((IB) + 4 * e); W_[e] = lp[0]; A_[e] = lp[1024]; }
    COOP_LOADS(0, lr, lk, lv, lw, la)
    for (int ib = 0; ib < n; ib += 8) {
        bf16_t nr[2][3], nk[2][3], nv[2][3], nw[2], na[2];
        { const int ibn = (ib + 8 < n) ? ib + 8 : ib; COOP_LOADS(ibn, nr, nk, nv, nw, na) }
        LAS float* bb = buf + ((ib >> 3) & 1) * (8 * 384);
#pragma unroll
        for (int e = 0; e < 2; ++e) {
            const int t = t0 + sd * (ib + 4 * e + rg);
            const float rc = bf2f(lr[e][1]), kc = bf2f(lk[e][1]), vc = bf2f(lv[e][1]);
            const float r = rc + mpr_r * (bf2f(lr[e][0]) - rc) + mnx_r * (bf2f(lr[e][2]) - rc);
            const float k = kc + mpr_k * (bf2f(lk[e][0]) - kc) + mnx_k * (bf2f(lk[e][2]) - kc);
            const float v = vc + mpr_v * (bf2f(lv[e][0]) - vc) + mnx_v * (bf2f(lv[e][2]) - vc);
            const float wraw = bf2f(lw[e]) + w0c, apre = bf2f(la[e]) + a0c;
            const float w = __expf(-0.60653066f * __builtin_amdgcn_rcpf(1.f + __expf(-wraw)));
            const float av = __builtin_amdgcn_rcpf(1.f + __expf(-apre));
            const float kkr = k * kkc; const float ssq = wave_sum(kkr * kkr);
            const float kk = kkr * rsqrtf(fmaxf(ssq, 1e-24f));
            const float kd = k * (1.f + (av - 1.f) * kac);
            const float bq = kk * av;
            const float cd = wave_sum(r * kd * rkc);
            LAS float* o = bb + (4 * e + rg) * 384;
            o[lane] = w; o[64 + lane] = kk; o[128 + lane] = bq; o[192 + lane] = kd; o[256 + lane] = r; o[320 + lane] = v;
            cbp[(long)sd * 8 * (ib + 4 * e)] = cd;
        }
        asm volatile("s_waitcnt lgkmcnt(0)" ::: "memory");
        __builtin_amdgcn_s_barrier();
        asm volatile("" ::: "memory");
        f32x4 vb_[2][20]; float vr_[2];
#define ROW_LOAD(U) { const LAS f32x4* V4 = (const LAS f32x4*)(bb + (U) * 384); \
            _Pragma("unroll") for (int j = 0; j < 4; ++j) { vb_[(U) & 1][j] = V4[16 + kq * 4 + j]; vb_[(U) & 1][4 + j] = V4[kq * 4 + j]; vb_[(U) & 1][8 + j] = V4[32 + kq * 4 + j]; \
                vb_[(U) & 1][12 + j] = V4[48 + kq * 4 + j]; vb_[(U) & 1][16 + j] = V4[64 + kq * 4 + j]; } \
            vr_[(U) & 1] = bb[(U) * 384 + 320 + myrow]; }
        ROW_LOAD(0)
#pragma unroll
        for (int u = 0; u < 8; ++u) {
            if (u < 7) ROW_LOAD(u + 1)
            __builtin_amdgcn_sched_barrier(0);
            const f32x4* cv = vb_[u & 1];
            const float vr = vr_[u & 1];
            const f32x2 vv2 = (f32x2){vr, vr};
            f32x2 a0 = St[0] * (f32x2){cv[0][0], cv[0][1]}, a1 = St[1] * (f32x2){cv[0][2], cv[0][3]};
            f32x2 a2 = St[2] * (f32x2){cv[1][0], cv[1][1]}, a3 = St[3] * (f32x2){cv[1][2], cv[1][3]};
            a0 += St[4] * (f32x2){cv[2][0], cv[2][1]}; a1 += St[5] * (f32x2){cv[2][2], cv[2][3]};
            a2 += St[6] * (f32x2){cv[3][0], cv[3][1]}; a3 += St[7] * (f32x2){cv[3][2], cv[3][3]};
            f32x2 P[8];
#pragma unroll
            for (int j = 0; j < 4; ++j) { const f32x4 w4 = cv[4 + j], d4 = cv[12 + j];
                P[2 * j] = St[2 * j] * (f32x2){w4[0], w4[1]} + vv2 * (f32x2){d4[0], d4[1]};
                P[2 * j + 1] = St[2 * j + 1] * (f32x2){w4[2], w4[3]} + vv2 * (f32x2){d4[2], d4[3]}; }
            const f32x2 as_ = (a0 + a1) + (a2 + a3);
            const float sa = quad_sum(as_[0] + as_[1]);
            const f32x2 nsa = (f32x2){-sa, -sa};
#pragma unroll
            for (int j = 0; j < 4; ++j) { const f32x4 b4 = cv[8 + j];
                St[2 * j] = nsa * (f32x2){b4[0], b4[1]} + P[2 * j]; St[2 * j + 1] = nsa * (f32x2){b4[2], b4[3]} + P[2 * j + 1]; }
            f32x2 y0 = St[0] * (f32x2){cv[16][0], cv[16][1]}, y1 = St[1] * (f32x2){cv[16][2], cv[16][3]};
            f32x2 y2 = St[2] * (f32x2){cv[17][0], cv[17][1]}, y3 = St[3] * (f32x2){cv[17][2], cv[17][3]};
            y0 += St[4] * (f32x2){cv[18][0], cv[18][1]}; y1 += St[5] * (f32x2){cv[18][2], cv[18][3]};
            y2 += St[6] * (f32x2){cv[19][0], cv[19][1]}; y3 += St[7] * (f32x2){cv[19][2], cv[19][3]};
            const f32x2 ys_ = (y0 + y1) + (y2 + y3);
            const float y = quad_sum(ys_[0] + ys_[1]);
            ypw[(long)sd * 512 * (ib + u)] = (bf16_t)cvt_pk_bf16(y, y);
        }
#undef ROW_LOAD
#pragma unroll
        for (int e = 0; e < 2; ++e) {
#pragma unroll
            for (int q = 0; q < 3; ++q) { lr[e][q] = nr[e][q]; lk[e][q] = nk[e][q]; lv[e][q] = nv[e][q]; }
            lw[e] = nw[e]; la[e] = na[e]; }
    }
#undef COOP_LOADS
    __syncthreads();
}
__device__ void phase_scan_main(const Args& a, LAS unsigned char* lds, bool comb) {
    if (comb) for (int cj = blockIdx.x; cj < 64; cj += gridDim.x) combine_chain(a, lds, cj >> 2, cj & 3);
    for (int j = blockIdx.x; j < 256; j += gridDim.x) { const int sq = j >> 3, h = j & 7;
        CoopJob A; A.row0 = NP + sq * SS; A.S = SS; A.h = h; A.dir = 0; A.i0 = 0; A.startp = nullptr; CoopJob B = A; B.dir = 1;
        scan_coop(a, lds, A, B, SS);
        __threadfence(); __syncthreads();
        rwkv_out_slice(a, A.row0, h); }
    for (int pj = blockIdx.x; pj < 8 * NSEGP; pj += gridDim.x) { const int id = 2 * pj, chain = id / NSEGP, seg = id % NSEGP;
        const int* fl = (const int*)(a.ws + OFF_FLAG) + chain;
        while (__hip_atomic_load(fl, __ATOMIC_ACQUIRE, __HIP_MEMORY_SCOPE_AGENT) < 4) __builtin_amdgcn_s_sleep(8);
        CoopJob A; A.row0 = 0; A.S = NP; A.h = chain >> 1; A.dir = chain & 1; A.i0 = seg * SEG; A.startp = seg ? sum_slot(a, chain, seg - 1, 1) : nullptr;
        CoopJob B = A; B.i0 = (seg + 1) * SEG; B.startp = sum_slot(a, chain, seg, 1);
        scan_coop(a, lds, A, B, SEG); }
}

struct RwkvOutConst { float mp[8], mn[8], lw[8], lb[8]; };
__device__ __forceinline__ void rwkv_out_load_const(const Args& a, int ch, RwkvOutConst& c) {
#pragma unroll
    for (int j = 0; j < 8; ++j) { c.mp[j] = a.in[I_MUP][1024 + ch + j]; c.mn[j] = a.in[I_MUN][1024 + ch + j]; c.lw[j] = a.in[I_LNW][ch + j]; c.lb[j] = a.in[I_LNB][ch + j]; }
}
__device__ __forceinline__ void rwkv_out_item(const Args& a, int row, int ch, int h, const RwkvOutConst& c) {
    const bf16_t* PR = (const bf16_t*)(a.ws + OFF_PR); const bf16_t* Y = (const bf16_t*)(a.ws + OFF_Y); const float* CB = (const float*)(a.ws + OFF_C);
    const bf16_t* G = (const bf16_t*)((const unsigned char*)a.out + OUT_OFF_G); bf16_t* MIX = (bf16_t*)(a.ws + OFF_H);
    int pos, S; if (row < NP) { pos = row; S = NP; } else { pos = (row - NP) % SS; S = SS; }
    const bool hp = pos > 0, hn = pos < S - 1;
    const u32x4 yf = *(const u32x4*)(Y + (size_t)row * 512 + ch), yb = *(const u32x4*)(Y + ((size_t)NTOK + row) * 512 + ch);
    const u32x4 gg = *(const u32x4*)(G + (size_t)row * 512 + ch);
    const bf16_t* vp = PR + (size_t)row * 1920 + 1024 + ch;
    const u32x4 vc = *(const u32x4*)vp;
    const u32x4 vpv = hp ? *(const u32x4*)(vp - 1920) : (u32x4){0u, 0u, 0u, 0u};
    const u32x4 vnx = hn ? *(const u32x4*)(vp + 1920) : (u32x4){0u, 0u, 0u, 0u};
    const float cs = CB[(size_t)row * 8 + h] + CB[((size_t)NTOK + row) * 8 + h];
    float y[8], gv[8], vs[8];
#pragma unroll
    for (int j = 0; j < 4; ++j) {
        y[2 * j] = lo_bf(yf[j]) + lo_bf(yb[j]); y[2 * j + 1] = hi_bf(yf[j]) + hi_bf(yb[j]);
        gv[2 * j] = lo_bf(gg[j]); gv[2 * j + 1] = hi_bf(gg[j]);
        const float c0 = lo_bf(vc[j]), c1 = hi_bf(vc[j]);
        vs[2 * j] = c0 + c.mp[2 * j] * (lo_bf(vpv[j]) - c0) + c.mn[2 * j] * (lo_bf(vnx[j]) - c0);
        vs[2 * j + 1] = c1 + c.mp[2 * j + 1] * (hi_bf(vpv[j]) - c1) + c.mn[2 * j + 1] * (hi_bf(vnx[j]) - c1);
    }
    float s = 0.f;
#pragma unroll
    for (int j = 0; j < 8; ++j) s += y[j];
    s += __shfl_xor(s, 1); s += __shfl_xor(s, 2); s += __shfl_xor(s, 4);
    const float mu = s * (1.f / 64.f);
    float q = 0.f;
#pragma unroll
    for (int j = 0; j < 8; ++j) { const float dlt = y[j] - mu; q += dlt * dlt; }
    q += __shfl_xor(q, 1); q += __shfl_xor(q, 2); q += __shfl_xor(q, 4);
    const float rs = rsqrtf(q * (1.f / 64.f) + LNX_EPS);
    float o[8];
#pragma unroll
    for (int j = 0; j < 8; ++j) o[j] = ((y[j] - mu) * rs * c.lw[j] + c.lb[j] + cs * vs[j]) * gv[j];
    u32x4 w; w.x = cvt_pk_bf16(o[0], o[1]); w.y = cvt_pk_bf16(o[2], o[3]); w.z = cvt_pk_bf16(o[4], o[5]); w.w = cvt_pk_bf16(o[6], o[7]);
    *(u32x4*)(MIX + (size_t)row * DM + 512 + ch) = w;
}
__device__ void phase_rwkv_out(const Args& a) {
    const int wave = threadIdx.x >> 6, lane = threadIdx.x & 63, ch = lane * 8, h = lane >> 3;
    RwkvOutConst c; rwkv_out_load_const(a, ch, c);
    for (int row = blockIdx.x * 8 + wave; row < NP; row += gridDim.x * 8) rwkv_out_item(a, row, ch, h, c);
}
__device__ void rwkv_out_slice(const Args& a, int row0, int h) {
    const int wave = threadIdx.x >> 6, lane = threadIdx.x & 63, ch = h * 64 + (lane & 7) * 8;
    RwkvOutConst c; rwkv_out_load_const(a, ch, c);
    for (int r = wave * 8 + (lane >> 3); r < SS; r += 64) rwkv_out_item(a, row0 + r, ch, h, c);
}

#define XB_TMO      128
#define XB_XCNT(j)  (256  + 64 * (j))
#define XB_XSUB(j)  (1280 + 64 * (j))
#define XB_XGEN(j)  (2304 + 64 * (j))
#define XB_TOP      3328
#define XB_TOPGEN   3392
#define XCD_BAR_WORDS 3456
#define XB_SPIN_CAP (1u << 18)
__device__ __forceinline__ unsigned xb_ld(unsigned* p)              { return __hip_atomic_load(p, __ATOMIC_RELAXED, __HIP_MEMORY_SCOPE_AGENT); }
__device__ __forceinline__ unsigned xb_add(unsigned* p, unsigned v) { return __hip_atomic_fetch_add(p, v, __ATOMIC_RELAXED, __HIP_MEMORY_SCOPE_AGENT); }
__device__ __forceinline__ unsigned xb_xcc_id() { return (unsigned)__builtin_amdgcn_s_getreg((3 << 11) | 20) & 0xFu; }
#define XB_SPIN(cond, bar) do { unsigned _sp = 0; while (cond) { __builtin_amdgcn_s_sleep(1); \
    if ((++_sp & 255u) == 0u) { if (xb_ld(&(bar)[XB_TMO])) break; if (_sp > XB_SPIN_CAP) { atomicAdd(&(bar)[XB_TMO], 1u); break; } } } } while (0)
struct XcdBarrier { unsigned* bar; unsigned x; volatile LAS unsigned* st; };
__device__ __forceinline__ XcdBarrier xcd_barrier_post(unsigned* bar, volatile LAS unsigned* st) {
    XcdBarrier b; b.bar = bar; b.x = xb_xcc_id(); b.st = st;
    if (threadIdx.x == 0) (void)xb_add(&bar[XB_XCNT(b.x)], 1u);
    return b;
}
__device__ __forceinline__ void xcd_barrier_complete(unsigned* bar, unsigned x, unsigned& nloc, unsigned& nx) {
    const unsigned G = gridDim.x * gridDim.y * gridDim.z;
    unsigned sum, cnt, mine, sp = 0u;
    for (;;) {
        sum = 0u; cnt = 0u; mine = 0u;
#pragma unroll
        for (unsigned j = 0; j < 16; ++j) { const unsigned c = xb_ld(&bar[XB_XCNT(j)]); sum += c; cnt += (c > 0u) ? 1u : 0u; mine = (j == x) ? c : mine; }
        if (sum == G) break;
        __builtin_amdgcn_s_sleep(1);
        if ((++sp & 255u) == 0u) { if (xb_ld(&bar[XB_TMO])) break; if (sp > XB_SPIN_CAP) { atomicAdd(&bar[XB_TMO], 1u); break; } }
    }
    nloc = mine > 0u ? mine : 1u; nx = cnt > 0u ? cnt : 1u;
}
__device__ __forceinline__ void xcd_barrier(const XcdBarrier& b) {
    asm volatile("s_waitcnt vmcnt(0)" ::: "memory");
    __syncthreads();
    if (threadIdx.x == 0) {
        unsigned* bar = b.bar;
        __builtin_amdgcn_s_waitcnt(0);
        unsigned nloc = b.st[0], nx = b.st[1];
        if (nloc == 0u) { xcd_barrier_complete(bar, b.x, nloc, nx); b.st[0] = nloc; b.st[1] = nx; }
        const unsigned old = xb_add(&bar[XB_XSUB(b.x)], 1u);
        const unsigned gen = old / nloc;
        if (old + 1u == (gen + 1u) * nloc) {
            __builtin_amdgcn_fence(__ATOMIC_RELEASE, "agent");
            asm volatile("s_waitcnt vmcnt(0)" ::: "memory");
            const unsigned og = xb_add(&bar[XB_TOP], 1u);
            const unsigned tg = og / nx;
            if (og + 1u == (tg + 1u) * nx) xb_add(&bar[XB_TOPGEN], 1u);
            else XB_SPIN(xb_ld(&bar[XB_TOPGEN]) == tg, bar);
            __builtin_amdgcn_fence(__ATOMIC_ACQUIRE, "agent");
            xb_add(&bar[XB_XGEN(b.x)], 1u);
            asm volatile("s_waitcnt vmcnt(0)" ::: "memory");
        } else {
            XB_SPIN(xb_ld(&bar[XB_XGEN(b.x)]) == gen, bar);
            __builtin_amdgcn_fence(__ATOMIC_ACQUIRE, "agent");
            asm volatile("s_waitcnt vmcnt(0)" ::: "memory");
        }
    }
    __syncthreads();
}

template <class Epi>
__device__ __forceinline__ void run_gemm(LAS unsigned char* lds, const bf16_t* A, const bf16_t* Bt, int N, int K, const Epi& E) {
    pg8::Gemm g; g.A = A; g.Bt = Bt; g.M = NTOK; g.N = N; g.K = K;
    pg8::StaticOrder S; S.init(NTOK, N, (int)gridDim.x, (int)blockIdx.x);
    pg8::gemm_phase<Epi>(lds, g, S, E);
}

__global__ void __launch_bounds__(512, 2) mega(Args a) {
    extern __shared__ __attribute__((aligned(16))) unsigned char shm[];
    LAS unsigned char* lds = (LAS unsigned char*)shm;
    cg::grid_group grid = cg::this_grid();
    volatile LAS unsigned* xst = (volatile LAS unsigned*)(lds + 131072);
    if (threadIdx.x == 0) { xst[0] = 0u; xst[1] = 0u; }
    __syncthreads();
    const XcdBarrier xb = xcd_barrier_post((unsigned*)(a.ws + OFF_BAR), xst);
#ifndef PHMASK
#define PHMASK 0xFFF
#endif
#ifndef DUP
#define DUP 0
#endif
#define PHASE(k, body) if (a.ph_lo <= (k) && (k) < a.ph_hi) { if ((k) != a.ph_lo) { if ((k) == 1) grid.sync(); else xcd_barrier(xb); } if constexpr ((PHMASK >> (k)) & 1) { body } }
    PHASE(0, phase_prep_weights(a, lds); phase_mod(a, lds); if (DUP & 8) { phase_prep_weights(a, lds); phase_mod(a, lds); })
    PHASE(1, phase_norm(a, a.in[I_XP], a.in[I_XS], a.in[I_G1], 0, 1024); if (DUP & 32) phase_norm(a, a.in[I_XP], a.in[I_XS], a.in[I_G1], 0, 1024);)
    PHASE(2, EpiIn E; E.QKV = (bf16_t*)a.out; E.PR = (bf16_t*)(a.ws + OFF_PR); E.qg = a.in[I_QG]; E.kg = a.in[I_KG];
             run_gemm(lds, (const bf16_t*)(a.ws + OFF_H), (const bf16_t*)(a.ws + OFF_WIN), NINP, 1024, E); if (DUP & 16) run_gemm(lds, (const bf16_t*)(a.ws + OFF_H), (const bf16_t*)(a.ws + OFF_WIN), NINP, 1024, E);)
    PHASE(3, phase_post_in(a); if (DUP & 64) { for (int q = 0; q < 10; ++q) grid.sync(); })
    PHASE(4, EpiLora E; E.LORA = (bf16_t*)(a.ws + OFF_LORA); E.G = (bf16_t*)((unsigned char*)a.out + OUT_OFF_G); E.w0 = a.in[I_W0]; E.a0 = a.in[I_A0];
             run_gemm(lds, (const bf16_t*)(a.ws + OFF_X5), (const bf16_t*)(a.ws + OFF_WL), 2560, 384, E);)
    PHASE(5, phase_attn(a, lds); if (DUP & 1) phase_attn(a, lds); phase_scan_pass1(a, lds); if (DUP & 4) phase_scan_pass1(a, lds);)
    PHASE(6, phase_scan_main(a, lds, true); if (DUP & 2) phase_scan_main(a, lds, false);)
    PHASE(7, phase_rwkv_out(a); if (DUP & 32) phase_rwkv_out(a);)
    PHASE(8, EpiRes E; E.out = a.out; E.xp = a.in[I_XP]; E.xs = a.in[I_XS]; E.mod = (const float*)(a.ws + OFF_MOD); E.gate_off = 2048;
             run_gemm(lds, (const bf16_t*)(a.ws + OFF_H), (const bf16_t*)(a.ws + OFF_WOUT), 1024, 1024, E);)
    PHASE(9, phase_norm(a, a.out, a.out + (size_t)NP * DM, a.in[I_G2], 3072, 4096);)
    PHASE(10, EpiFf1 E; E.HID = (bf16_t*)(a.ws + OFF_HID);
             run_gemm(lds, (const bf16_t*)(a.ws + OFF_H), (const bf16_t*)(a.ws + OFF_WFF1), DFF, 1024, E); if (DUP & 16) run_gemm(lds, (const bf16_t*)(a.ws + OFF_H), (const bf16_t*)(a.ws + OFF_WFF1), DFF, 1024, E);)
    PHASE(11, EpiRes E; E.out = a.out; E.xp = nullptr; E.xs = nullptr; E.mod = (const float*)(a.ws + OFF_MOD); E.gate_off = 5120;
             run_gemm(lds, (const bf16_t*)(a.ws + OFF_HID), (const bf16_t*)(a.ws + OFF_WFF2), 1024, DFF, E);)
}

#ifndef N_LAUNCHES
#define N_LAUNCHES 1
#endif

extern "C" void kernel_launch(void* const* d_in, const int* in_sizes, int n_in, void* d_out, int out_size, void* d_ws, size_t ws_size, hipStream_t stream) {
    static int grid = 0;
    if (grid == 0) {
        if (n_in != 27 || out_size != NTOK * DM || ws_size < WS_END) { fprintf(stderr, "kernel_launch: unexpected shapes (n_in %d out %d ws %zu need %zu)\n", n_in, out_size, ws_size, (size_t)WS_END); grid = -1; return; }
        int dev = 0, cus = 0, per_cu = 0;
        hipGetDevice(&dev);
        hipDeviceGetAttribute(&cus, hipDeviceAttributeMultiprocessorCount, dev);
        hipFuncSetAttribute((const void*)mega, hipFuncAttributeMaxDynamicSharedMemorySize, LDS_BYTES);
        hipOccupancyMaxActiveBlocksPerMultiprocessor(&per_cu, (const void*)mega, 512, LDS_BYTES);
        if (per_cu < 1) { fprintf(stderr, "kernel_launch: occupancy query says %d blocks/CU\n", per_cu); per_cu = 1; }
        grid = cus * per_cu;
        (void)hipGetLastError();
    }
    if (grid < 0) return;
    if (hipMemsetAsync((char*)d_ws + OFF_BAR, 0, BAR_BYTES, stream) != hipSuccess) { fprintf(stderr, "kernel_launch: memset of the barrier words failed\n"); return; }
    Args a{};
    for (int i = 0; i < 27; ++i) a.in[i] = (const float*)d_in[i];
    a.out = (float*)d_out; a.ws = (unsigned char*)d_ws;
    if (N_LAUNCHES == 1) {
        a.ph_lo = 0; a.ph_hi = NPH;
        void* args[] = {&a};
        hipError_t e = hipLaunchCooperativeKernel((const void*)mega, dim3(grid), dim3(512), args, LDS_BYTES, stream);
        if (e != hipSuccess) fprintf(stderr, "cooperative launch failed: %s (grid %d)\n", hipGetErrorString(e), grid);
    } else {
        for (int ph = 0; ph < NPH; ++ph) {
            a.ph_lo = ph; a.ph_hi = ph + 1;
            void* args[] = {&a};
            hipError_t e = hipLaunchCooperativeKernel((const void*)mega, dim3(grid), dim3(512), args, LDS_BYTES, stream);
            if (e != hipSuccess) fprintf(stderr, "cooperative launch failed: %s (grid %d)\n", hipGetErrorString(e), grid);
        }
    }
}
```
